# Optimizing an MI355X kernel written in HIP

```python
import jax, jax.numpy as jnp
from jax import lax
import numpy as np

D_MODEL = 1024
BATCH = 4
SEQ = 8192
DEPTH = 1
DEC_BATCH = 16
DEC_SEQ = 16
PAST_LEN = 1024

CHUNK = 64
D_CONV = D_MODEL // 2
CONV_W = 3
HG_HEADS = 4
HG_KDIM = 128
HG_VDIM = 128
HG_W = HG_HEADS * HG_KDIM
N_MEM = 256
X_HEADS = 4
X_HEAD_DIM = D_MODEL // X_HEADS
D_FF = 4 * D_MODEL
N_BRANCH = 2
IN_COLS = 3 * D_CONV + 4 * HG_W + N_BRANCH * D_MODEL
EPS = 1e-6

kernel_name = "hybrid_conv_hgrn2_memxattn_step"

F32 = jnp.float32


def _rmsnorm(x, g):
    xf = x.astype(F32)
    y = xf * lax.rsqrt(jnp.mean(xf * xf, axis=-1, keepdims=True) + EPS)
    return (y * g.astype(F32)).astype(x.dtype)


def _causal_conv(u, prefix, w):
    T = u.shape[1]
    padded = jnp.concatenate([prefix.astype(u.dtype), u], axis=1)
    y = padded[:, 0:T] * w[0]
    for j in range(1, CONV_W):
        y = y + padded[:, j:j + T] * w[j]
    return y, padded[:, T:]


def _hgrn_block(q, k, v, logf, S0):
    L = q.shape[2]
    b = jnp.cumsum(logf, axis=2)
    causal = jnp.tril(jnp.ones((L, L), dtype=bool))
    diff = b[:, :, :, None, :] - b[:, :, None, :, :]
    decay = jnp.exp(jnp.where(causal[None, None, :, :, None], diff, -jnp.inf))
    scores = jnp.einsum('bhtk,bhsk,bhtsk->bhts', q, k, decay)
    o = jnp.einsum('bhts,bhsv->bhtv', scores, v) + jnp.einsum('bhtk,bhkv->bhtv', q * jnp.exp(b), S0)
    b_last = b[:, :, -1:, :]
    S = jnp.exp(b_last[:, :, 0, :])[..., None] * S0 + jnp.einsum('bhsk,bhsv->bhkv', k * jnp.exp(b_last - b), v)
    return o, S


def _hgrn_recurrence(q, k, v, logf, S0):
    B, H, T, K = q.shape
    if T <= CHUNK:
        return _hgrn_block(q, k, v, logf, S0)
    nc = T // CHUNK

    def to_blocks(a):
        return a.reshape(B, H, nc, CHUNK, a.shape[-1]).transpose(2, 0, 1, 3, 4)

    def step(S, blk):
        qb, kb, vb, fb = blk
        o, S = _hgrn_block(qb, kb, vb, fb, S)
        return S, o

    S, o = lax.scan(step, S0, (to_blocks(q), to_blocks(k), to_blocks(v), to_blocks(logf)))
    o = o.transpose(1, 2, 0, 3, 4).reshape(B, H, T, v.shape[-1])
    return o, S


def _mixer(h, conv_prefix, S0, w_in, conv_w, lb, hg_norm, w_conv_out, w_hg_out, w_o):
    Bn, T, _ = h.shape
    splits = (D_CONV, 2 * D_CONV, 3 * D_CONV,
              3 * D_CONV + HG_W, 3 * D_CONV + 2 * HG_W, 3 * D_CONV + 3 * HG_W, 3 * D_CONV + 4 * HG_W,
              3 * D_CONV + 4 * HG_W + D_MODEL)
    proj = h @ w_in
    cb, cc, cx, hq, hf, hi, hg, ga, gb = jnp.split(proj, splits, axis=-1)
    y_conv, conv_state = _causal_conv(cc * cx, conv_prefix, conv_w)
    y_a = (cb * y_conv) @ w_conv_out
    def heads(a):
        return a.astype(F32).reshape(Bn, T, HG_HEADS, -1).transpose(0, 2, 1, 3)
    q = jax.nn.silu(heads(hq))
    lbh = lb.astype(F32).reshape(1, HG_HEADS, 1, HG_KDIM)
    f = lbh + (1.0 - lbh) * jax.nn.sigmoid(heads(hf))
    logf = jnp.log(f)
    k = 1.0 - f
    v = heads(hi)
    o, S = _hgrn_recurrence(q, k, v, logf, S0.astype(F32))
    o = o.transpose(0, 2, 1, 3)
    o = o * lax.rsqrt(jnp.mean(o * o, axis=-1, keepdims=True) + EPS) * hg_norm.astype(F32)
    o = o * jax.nn.silu(hg.astype(F32).reshape(Bn, T, HG_HEADS, HG_VDIM))
    y_b = o.reshape(Bn, T, HG_W).astype(h.dtype) @ w_hg_out
    merged = jax.nn.sigmoid(ga) * y_a + jax.nn.sigmoid(gb) * y_b
    return merged @ w_o, conv_state, S


def _mem_kv(mem, g, w_xk, w_xv):
    Bn = mem.shape[0]
    mh = _rmsnorm(mem, g)
    mk = (mh @ w_xk).reshape(Bn, N_MEM, X_HEADS, X_HEAD_DIM)
    mv = (mh @ w_xv).reshape(Bn, N_MEM, X_HEADS, X_HEAD_DIM)
    return mk, mv


def _cross_attn(h, mk, mv, w_xq, w_xo):
    Bn, T, _ = h.shape
    q = (h @ w_xq).reshape(Bn, T, X_HEADS, X_HEAD_DIM)
    s = jnp.einsum('bthd,bmhd->bhtm', q, mk.astype(q.dtype)).astype(F32) * (X_HEAD_DIM ** -0.5)
    p = jax.nn.softmax(s, axis=-1).astype(h.dtype)
    o = jnp.einsum('bhtm,bmhd->bthd', p, mv.astype(h.dtype)).reshape(Bn, T, D_MODEL)
    return o @ w_xo


def _ffn(h, w_up, w_down):
    a = jax.nn.relu(h @ w_up)
    return (a * a) @ w_down


def _layer(x, conv_prefix, S0, mk, mv, lb, norm_mix, w_in, conv_w, hg_norm, w_conv_out, w_hg_out, w_o,
           norm_x, w_xq, w_xo, norm_ffn, w_up, w_down):
    m, conv_state, S = _mixer(_rmsnorm(x, norm_mix), conv_prefix, S0, w_in, conv_w, lb, hg_norm,
                              w_conv_out, w_hg_out, w_o)
    x = x + m
    x = x + _cross_attn(_rmsnorm(x, norm_x), mk, mv, w_xq, w_xo)
    x = x + _ffn(_rmsnorm(x, norm_ffn), w_up, w_down)
    return x, conv_state, S


def setup_inputs(seed: int = 0) -> dict:
    key = jax.random.key(seed)
    ks = jax.random.split(key, 32)
    nrm = lambda k, shape, s: jax.random.normal(k, shape, F32) * s
    gain = lambda k, shape: 1.0 + 0.05 * jax.random.normal(k, shape, F32)
    return {
        "x_prompt": nrm(ks[0], (BATCH, SEQ, D_MODEL), 1.0),
        "x_sample": nrm(ks[1], (DEC_BATCH, DEC_SEQ, D_MODEL), 1.0),
        "mem_prompt": nrm(ks[2], (BATCH, N_MEM, D_MODEL), 1.0),
        "state_conv": nrm(ks[3], (DEPTH, DEC_BATCH, CONV_W - 1, D_CONV), 1.0),
        "state_hgrn": nrm(ks[4], (DEPTH, DEC_BATCH, HG_HEADS, HG_KDIM, HG_VDIM), 0.5),
        "cache_mem_k": nrm(ks[5], (DEPTH, DEC_BATCH, N_MEM, X_HEADS, X_HEAD_DIM), 1.0),
        "cache_mem_v": nrm(ks[6], (DEPTH, DEC_BATCH, N_MEM, X_HEADS, X_HEAD_DIM), 1.0),
        "norm_mix": gain(ks[7], (DEPTH, D_MODEL)),
        "w_in": nrm(ks[8], (DEPTH, D_MODEL, IN_COLS), D_MODEL ** -0.5),
        "conv_w": nrm(ks[9], (DEPTH, CONV_W, D_CONV), CONV_W ** -0.5),
        "hg_lb": nrm(ks[10], (DEPTH + 1, HG_W), 0.5),
        "hg_norm": gain(ks[11], (DEPTH, HG_VDIM)),
        "w_conv_out": nrm(ks[12], (DEPTH, D_CONV, D_MODEL), D_CONV ** -0.5),
        "w_hg_out": nrm(ks[13], (DEPTH, HG_W, D_MODEL), HG_W ** -0.5),
        "w_o": nrm(ks[14], (DEPTH, D_MODEL, D_MODEL), D_MODEL ** -0.5),
        "norm_x": gain(ks[15], (DEPTH, D_MODEL)),
        "norm_mem": gain(ks[16], (DEPTH, D_MODEL)),
        "w_xq": nrm(ks[17], (DEPTH, D_MODEL, D_MODEL), D_MODEL ** -0.5),
        "w_xk": nrm(ks[18], (DEPTH, D_MODEL, D_MODEL), D_MODEL ** -0.5),
        "w_xv": nrm(ks[19], (DEPTH, D_MODEL, D_MODEL), D_MODEL ** -0.5),
        "w_xo": nrm(ks[20], (DEPTH, D_MODEL, D_MODEL), D_MODEL ** -0.5),
        "norm_ffn": gain(ks[21], (DEPTH, D_MODEL)),
        "w_up": nrm(ks[22], (DEPTH, D_MODEL, D_FF), D_MODEL ** -0.5),
        "w_down": nrm(ks[23], (DEPTH, D_FF, D_MODEL), D_FF ** -0.5),
        "norm_final": gain(ks[24], (D_MODEL,)),
    }


def reference(x_prompt, x_sample, mem_prompt, state_conv, state_hgrn, cache_mem_k, cache_mem_v,
              norm_mix, w_in, conv_w, hg_lb, hg_norm, w_conv_out, w_hg_out, w_o,
              norm_x, norm_mem, w_xq, w_xk, w_xv, w_xo, norm_ffn, w_up, w_down, norm_final):
    lb_all = jnp.cumsum(jax.nn.softmax(hg_lb.astype(F32), axis=0), axis=0)
    xp, xs = x_prompt, x_sample
    Bp = x_prompt.shape[0]
    conv_p, hg_p, mk_p_l, mv_p_l, conv_s, hg_s = [], [], [], [], [], []
    for l in range(DEPTH):
        shared = dict(lb=lb_all[l], norm_mix=norm_mix[l], w_in=w_in[l], conv_w=conv_w[l], hg_norm=hg_norm[l],
                      w_conv_out=w_conv_out[l], w_hg_out=w_hg_out[l], w_o=w_o[l], norm_x=norm_x[l],
                      w_xq=w_xq[l], w_xo=w_xo[l], norm_ffn=norm_ffn[l], w_up=w_up[l], w_down=w_down[l])
        mk_p, mv_p = _mem_kv(mem_prompt, norm_mem[l], w_xk[l], w_xv[l])
        prefix0 = jnp.zeros((Bp, CONV_W - 1, D_CONV), xp.dtype)
        S0 = jnp.zeros((Bp, HG_HEADS, HG_KDIM, HG_VDIM), F32)
        xp, cst_p, S_p = _layer(xp, prefix0, S0, mk_p, mv_p, **shared)
        conv_p.append(cst_p.astype(x_prompt.dtype))
        hg_p.append(S_p.astype(x_prompt.dtype))
        mk_p_l.append(mk_p)
        mv_p_l.append(mv_p)
        xs, cst_s, S_s = _layer(xs, state_conv[l], state_hgrn[l], cache_mem_k[l], cache_mem_v[l], **shared)
        conv_s.append(cst_s.astype(x_sample.dtype))
        hg_s.append(S_s.astype(x_sample.dtype))
    y_prompt = _rmsnorm(xp, norm_final)
    y_sample = _rmsnorm(xs, norm_final)
    return (y_prompt, y_sample, jnp.stack(conv_p), jnp.stack(hg_p), jnp.stack(mk_p_l), jnp.stack(mv_p_l),
            jnp.stack(conv_s), jnp.stack(hg_s))
```

```cpp
#include <hip/hip_runtime.h>
#include <hip/hip_cooperative_groups.h>
#include <cstdio>
namespace cg = cooperative_groups;

#define LAS __attribute__((address_space(3)))
typedef unsigned short bf16_t;
typedef short bf16x8 __attribute__((ext_vector_type(8)));
typedef float f32x4 __attribute__((ext_vector_type(4)));
typedef unsigned u32x4 __attribute__((ext_vector_type(4)));
typedef unsigned u32x2 __attribute__((ext_vector_type(2)));
typedef _Float16 f16x8 __attribute__((ext_vector_type(8)));

constexpr int DM = 1024, NP = 32768, NS = 256, NTOK = NP + NS, NTOKP = NTOK + 256;
constexpr int NCHUNK_UNITS = 2048 + 64;
constexpr float EPS = 1e-6f;
constexpr int NTHREADS = 512;
constexpr int STAGE_LDS = 131072, EXTRA_LDS = 8192, LDS_BYTES = STAGE_LDS + EXTRA_LDS;

constexpr size_t SZ_S = (size_t)NTOK * 512 * 2;
constexpr size_t OFF_WIN = 0;
constexpr size_t OFF_WCONV = OFF_WIN + (size_t)5632 * 1024 * 2;
constexpr size_t OFF_WHG = OFF_WCONV + (size_t)1024 * 512 * 2;
constexpr size_t OFF_WO = OFF_WHG + (size_t)1024 * 512 * 2;
constexpr size_t OFF_WXQ = OFF_WO + (size_t)1024 * 1024 * 2;
constexpr size_t OFF_WXKV = OFF_WXQ + (size_t)1024 * 1024 * 2;
constexpr size_t OFF_WXO = OFF_WXKV + (size_t)2048 * 1024 * 2;
constexpr size_t OFF_WUP = OFF_WXO + (size_t)1024 * 1024 * 2;
constexpr size_t OFF_WDOWN = OFF_WUP + (size_t)4096 * 1024 * 2;
constexpr size_t OFF_KB = OFF_WDOWN + (size_t)1024 * 4096 * 2;
constexpr size_t OFF_VT = OFF_KB + (size_t)20 * 256 * 1024 * 2;
constexpr size_t OFF_MEMB = OFF_VT + (size_t)20 * 256 * 1024 * 2;
constexpr size_t OFF_LB = OFF_MEMB + (size_t)1024 * 1024 * 2;
constexpr size_t OFF_RSTD1 = OFF_LB + 2048;
constexpr size_t OFF_SS2 = OFF_RSTD1 + (size_t)NTOKP * 4;
constexpr size_t OFF_SS3 = OFF_SS2 + (size_t)NTOKP * 16 * 4;
constexpr size_t OFF_SS4 = OFF_SS3 + (size_t)NTOKP * 16 * 4;
constexpr size_t OFF_LSUM = OFF_SS4 + (size_t)NTOKP * 16 * 4;
constexpr size_t OFF_DEC = OFF_LSUM + (size_t)NTOKP * 16 * 4;
constexpr size_t OFF_XB = OFF_DEC + (size_t)NCHUNK_UNITS * 128 * 4;
constexpr size_t OFF_ARENA = OFF_XB + (size_t)NTOK * 1024 * 2;
constexpr size_t WS_END = OFF_ARENA + 10 * SZ_S + (1u << 20);
constexpr size_t AR_CB = 0, AR_U = SZ_S, AR_Q = 2 * SZ_S, AR_LOGF = 3 * SZ_S, AR_V = 4 * SZ_S, AR_G = 5 * SZ_S, AR_GA = 6 * SZ_S, AR_GB = 8 * SZ_S;
constexpr size_t AR_X1B = 0, AR_QB = 2 * SZ_S, AR_P = 6 * SZ_S, AR_AO = 2 * SZ_S, AR_X2B = 8 * SZ_S, AR_HID = 0;
constexpr size_t OUT_Y = 0;
constexpr size_t OUT_CONVP = (size_t)NTOK * 1024;
constexpr size_t OUT_HGP = OUT_CONVP + 4 * 2 * 512;
constexpr size_t OUT_MEMK = OUT_HGP + (size_t)4 * 4 * 16384;
constexpr size_t OUT_MEMV = OUT_MEMK + (size_t)4 * 256 * 1024;
constexpr size_t OUT_CONVS = OUT_MEMV + (size_t)4 * 256 * 1024;
constexpr size_t OUT_HGS = OUT_CONVS + 16 * 2 * 512;

struct Params { const float* in[25]; float* out; unsigned char* ws; };

typedef float f32x2_ __attribute__((ext_vector_type(2)));
typedef __bf16 bf16x2_ __attribute__((ext_vector_type(2)));
__device__ __forceinline__ unsigned cvt_pk_bf16(float lo, float hi) { const f32x2_ v = {lo, hi}; const bf16x2_ b = __builtin_convertvector(v, bf16x2_); return __builtin_bit_cast(unsigned, b); }
__device__ __forceinline__ bf16_t f2bf(float f) { return (bf16_t)(cvt_pk_bf16(f, 0.f) & 0xffffu); }
__device__ __forceinline__ float bf2f(bf16_t b) { return __uint_as_float(((unsigned)b) << 16); }
__device__ __forceinline__ float bf_lo(unsigned w) { return __uint_as_float(w << 16); }
__device__ __forceinline__ float bf_hi(unsigned w) { return __uint_as_float(w & 0xffff0000u); }
__device__ __forceinline__ float sigmoidf_(float z) { return __builtin_amdgcn_rcpf(1.0f + __expf(-z)); }
__device__ __forceinline__ void store8_bf16(bf16_t* p, f32x4 v0, f32x4 v1) {
    u32x4 w; w.x = cvt_pk_bf16(v0[0], v0[1]); w.y = cvt_pk_bf16(v0[2], v0[3]); w.z = cvt_pk_bf16(v1[0], v1[1]); w.w = cvt_pk_bf16(v1[2], v1[3]); *(u32x4*)p = w; }
__device__ __forceinline__ void load8_bf16(const bf16_t* p, f32x4& v0, f32x4& v1) {
    const u32x4 w = *(const u32x4*)p; v0[0] = bf_lo(w.x); v0[1] = bf_hi(w.x); v0[2] = bf_lo(w.y); v0[3] = bf_hi(w.y); v1[0] = bf_lo(w.z); v1[1] = bf_hi(w.z); v1[2] = bf_lo(w.w); v1[3] = bf_hi(w.w); }

__device__ __forceinline__ float sum16(const float* p) { const f32x4 a = *(const f32x4*)p, b = *(const f32x4*)(p + 4), c = *(const f32x4*)(p + 8), d = *(const f32x4*)(p + 12);
    return (((a[0] + a[1]) + (a[2] + a[3])) + ((b[0] + b[1]) + (b[2] + b[3]))) + (((c[0] + c[1]) + (c[2] + c[3])) + ((d[0] + d[1]) + (d[2] + d[3]))); }
namespace pg8 {
constexpr int BM = 256, BK = 64, HALF = 128, HTB = HALF * BK * 2, NXCD = 8, WGM = 8;
__device__ __forceinline__ int lds_byte(int r, int c) { const int st = (r >> 4) * 2 + (c >> 5), rr = r & 15, cc = c & 31, ob = rr * 64 + cc * 2; return st * 1024 + (ob ^ (((ob >> 9) & 1) << 5)); }
__device__ __forceinline__ void stage_rc(int b, int& R, int& C) { const int st = b / 1024, sb = b % 1024, swz = sb ^ (((sb >> 9) & 1) << 5); R = (st >> 1) * 16 + swz / 64; C = (st & 1) * 32 + (swz % 64) / 2; }
__device__ __forceinline__ int perm32(int rho) { const int n = rho >> 4, i = rho & 15; return 8 * (i >> 2) + 4 * n + (i & 3); }

struct Unit { int pm, pn, row0, h, batch, nv; };
struct Gemm { const bf16_t* A; const bf16_t* Bt; int lda, ldb, K; };

struct StaticOrder {
    int nM, nN, nwg, G, c; const bf16_t* A; const bf16_t* Bt; int lda, ldb;
    __device__ void init(const Gemm& g, int M, int N, int G_, int c_) { nM = M / BM; nN = N / BM; nwg = nM * nN; G = G_; c = c_; A = g.A; Bt = g.Bt; lda = g.lda; ldb = g.ldb; }
    __device__ bool next(int i, Unit& u) const {
        const long L = (long)i * G + c; if (L >= nwg) return false;
        int wgid = (int)L; { const int q = nwg / NXCD, r = nwg % NXCD, xcd = wgid % NXCD, off = wgid / NXCD; wgid = (xcd < r ? xcd * (q + 1) : r * (q + 1) + (xcd - r) * q) + off; }
        const int nig = WGM * nN, gid = wgid / nig, fm = gid * WGM, gsz = (nM - fm) < WGM ? (nM - fm) : WGM;
        u.pm = fm + ((wgid % nig) % gsz); u.pn = (wgid % nig) / gsz; u.row0 = u.pm * BM; u.h = 0; u.batch = 0; u.nv = 256; return true;
    }
    __device__ __forceinline__ const char* aptr(const Unit& u) const { return (const char*)A + (size_t)u.pm * 256 * lda * 2; }
    __device__ __forceinline__ const char* bptr(const Unit& u) const { return (const char*)Bt + (size_t)u.pn * 256 * ldb * 2; }
};
struct AttnOrder {
    int G, c; const bf16_t* A; const bf16_t* B; int mode;
    __device__ bool next(int i, Unit& u) const {
        const int L = i * G + c; if (L >= 576) return false;
        if (L < 512) { u.batch = L >> 7; u.h = (L >> 5) & 3; u.row0 = u.batch * 8192 + (L & 31) * 256; u.nv = 256; }
        else { const int s = L - 512; u.batch = 4 + (s >> 2); u.h = s & 3; u.row0 = NP + (s >> 2) * 16; u.nv = 16; }
        u.pm = 0; u.pn = 0; return true;
    }
    __device__ __forceinline__ const char* aptr(const Unit& u) const { return (const char*)(A + (size_t)u.row0 * 1024 + u.h * 256); }
    __device__ __forceinline__ const char* bptr(const Unit& u) const {
        return mode == 0 ? (const char*)(B + (size_t)u.batch * 256 * 1024 + u.h * 256) : (const char*)(B + ((size_t)u.batch * 4 + u.h) * 65536); }
};

template <class Epi, class Sched>
__device__ __forceinline__ void gemm_phase(LAS unsigned char* lds, const Gemm g, const Sched& S, const Epi& E) {
    int tid_ = threadIdx.x; asm volatile("" : "+v"(tid_));
    const int tid = tid_, wid = __builtin_amdgcn_readfirstlane(tid >> 6), lane = tid & 63, wr = wid >> 2, wc = wid & 3, fr = lane & 15, fq = lane >> 4;
    const int K = g.K, nt = K / BK;
    unsigned voffA[2], voffB[2];
#pragma unroll
    for (int i = 0; i < 2; ++i) { int R, C; stage_rc(tid * 16 + i * 8192, R, C); const int Rb = Epi::PERM ? ((R & ~31) + perm32(R & 31)) : R;
        voffA[i] = (unsigned)(R * g.lda + C) * 2u; voffB[i] = (unsigned)(Rb * g.ldb + C) * 2u; }
    const size_t kstep = (size_t)(BK * 2);
    const size_t hA = (size_t)HALF * g.lda * 2, hB = (size_t)HALF * g.ldb * 2;
    const unsigned ldsw = (unsigned)wid * 1024u;
    const int aoff = lds_byte(wr * 64 + fr, fq * 8), boff = lds_byte(wc * 32 + fr, fq * 8);
#define PG8_SA(b, h) (((b) * 2 + (h)) * HTB)
#define PG8_SB(b, h) ((4 + (b) * 2 + (h)) * HTB)
#define PG8_STAGE(bufoff, gbase, voff) do { _Pragma("unroll") for (int _i = 0; _i < 2; ++_i) \
        __builtin_amdgcn_global_load_lds((const unsigned*)((const char*)(gbase) + (voff)[_i]), (LAS unsigned*)(lds + (bufoff) + ldsw + _i * 8192), 16, 0, 0); } while (0)
#define PG8_LDA(dst, b, h) do { _Pragma("unroll") for (int m = 0; m < 4; ++m) _Pragma("unroll") for (int k = 0; k < 2; ++k) dst[m][k] = *(const LAS bf16x8*)(lds + PG8_SA(b, h) + aoff + m * 2048 + k * 1024); } while (0)
#define PG8_LDB(dst, b, h) do { _Pragma("unroll") for (int n = 0; n < 2; ++n) _Pragma("unroll") for (int k = 0; k < 2; ++k) dst[n][k] = *(const LAS bf16x8*)(lds + PG8_SB(b, h) + boff + n * 2048 + k * 1024); } while (0)
#define PG8_MMA(ai, bj, At, Bt) do { __builtin_amdgcn_s_setprio(1); _Pragma("unroll") for (int m = 0; m < 4; ++m) _Pragma("unroll") for (int n = 0; n < 2; ++n) _Pragma("unroll") for (int k = 0; k < 2; ++k) \
        acc[ai][bj][m][n] = __builtin_amdgcn_mfma_f32_16x16x32_bf16(Bt[n][k], At[m][k], acc[ai][bj][m][n], 0, 0, 0); __builtin_amdgcn_s_setprio(0); } while (0)
#define PG8_WAIT_V(n) asm volatile("s_waitcnt vmcnt(" #n ")" ::: "memory")
#define PG8_WAIT_L(n) asm volatile("s_waitcnt lgkmcnt(" #n ")" ::: "memory")
#define PG8_BAR __builtin_amdgcn_s_barrier()
#define PG8_SCHED __builtin_amdgcn_sched_barrier(0)
    Unit cur, nxt; int ui = 0;
    if (!S.next(0, cur)) return;
    f32x4 acc[2][2][4][2];
#pragma unroll
    for (int a = 0; a < 2; ++a)
#pragma unroll
        for (int b = 0; b < 2; ++b)
#pragma unroll
            for (int m = 0; m < 4; ++m)
#pragma unroll
                for (int n = 0; n < 2; ++n) acc[a][b][m][n] = (f32x4){0.f, 0.f, 0.f, 0.f};
    bf16x8 At[4][2], B0[2][2], B1[2][2];
    const char* cA = S.aptr(cur); const char* cB = S.bptr(cur);
    PG8_STAGE(PG8_SB(0, 0), cB, voffB); PG8_STAGE(PG8_SA(0, 0), cA, voffA); PG8_STAGE(PG8_SB(0, 1), cB + hB, voffB); PG8_STAGE(PG8_SA(0, 1), cA + hA, voffA);
    if (wr == 1) PG8_BAR;
    PG8_WAIT_V(4); PG8_BAR;
    PG8_STAGE(PG8_SB(1, 0), cB + kstep, voffB); PG8_STAGE(PG8_SA(1, 0), cA + kstep, voffA); PG8_STAGE(PG8_SB(1, 1), cB + hB + kstep, voffB);
    PG8_WAIT_V(6); PG8_BAR;
    for (;;) {
        const bool has_next = S.next(ui + 1, nxt);
        const char* nA = has_next ? S.aptr(nxt) : cA; const char* nB = has_next ? S.bptr(nxt) : cB;
#pragma clang loop unroll(disable)
        for (int t = 0; t < nt; t += 2) {
            const bool last = (t == nt - 2);
            const char* a1 = cA + (size_t)(t + 1) * kstep;
            const char* a2 = last ? nA : cA + (size_t)(t + 2) * kstep; const char* b2 = last ? nB : cB + (size_t)(t + 2) * kstep;
            const char* a3 = a2 + kstep; const char* b3 = b2 + kstep;
            PG8_LDB(B0, 0, 0); PG8_SCHED; PG8_LDA(At, 0, 0); PG8_STAGE(PG8_SA(1, 1), a1 + hA, voffA);
            PG8_WAIT_L(8); PG8_BAR; PG8_WAIT_L(0); PG8_MMA(0, 0, At, B0); PG8_BAR; PG8_SCHED;
            PG8_LDB(B1, 0, 1); PG8_STAGE(PG8_SB(0, 0), b2, voffB);
            PG8_BAR; PG8_WAIT_L(0); PG8_MMA(0, 1, At, B1); PG8_BAR;
            PG8_LDA(At, 0, 1); PG8_STAGE(PG8_SA(0, 0), a2, voffA);
            PG8_BAR; PG8_WAIT_L(0); PG8_MMA(1, 0, At, B0); PG8_BAR; PG8_SCHED;
            PG8_STAGE(PG8_SB(0, 1), b2 + hB, voffB);
            PG8_WAIT_V(6); PG8_BAR; PG8_MMA(1, 1, At, B1); PG8_BAR;
            PG8_LDB(B0, 1, 0); PG8_SCHED; PG8_LDA(At, 1, 0); PG8_STAGE(PG8_SA(0, 1), a2 + hA, voffA);
            PG8_WAIT_L(8); PG8_BAR; PG8_WAIT_L(0); PG8_MMA(0, 0, At, B0); PG8_BAR; PG8_SCHED;
            PG8_LDB(B1, 1, 1); PG8_STAGE(PG8_SB(1, 0), b3, voffB);
            PG8_BAR; PG8_WAIT_L(0); PG8_MMA(0, 1, At, B1); PG8_BAR;
            PG8_LDA(At, 1, 1); PG8_STAGE(PG8_SA(1, 0), a3, voffA);
            PG8_BAR; PG8_WAIT_L(0); PG8_MMA(1, 0, At, B0); PG8_BAR; PG8_SCHED;
            PG8_STAGE(PG8_SB(1, 1), b3 + hB, voffB);
            PG8_WAIT_V(6); PG8_BAR; PG8_MMA(1, 1, At, B1); PG8_BAR;
        }
        E(acc, cur, wr, wc, fr, fq, lds + STAGE_LDS);
        if (!has_next) break;
#pragma unroll
        for (int a = 0; a < 2; ++a)
#pragma unroll
            for (int b = 0; b < 2; ++b)
#pragma unroll
                for (int m = 0; m < 4; ++m)
#pragma unroll
                    for (int n = 0; n < 2; ++n) acc[a][b][m][n] = (f32x4){0.f, 0.f, 0.f, 0.f};
        cur = nxt; cA = nA; cB = nB; ++ui;
    }
    PG8_WAIT_V(0);
    if (wr == 0) PG8_BAR;
    PG8_BAR;
#undef PG8_SA
#undef PG8_SB
#undef PG8_STAGE
#undef PG8_LDA
#undef PG8_LDB
#undef PG8_MMA
#undef PG8_WAIT_V
#undef PG8_WAIT_L
#undef PG8_BAR
#undef PG8_SCHED
}
}
using pg8::Unit;
typedef f32x4 AccT[2][2][4][2];


struct EpiProj {
    static constexpr bool PERM = true;
    bf16_t *CB, *U, *Q, *V, *G, *GA, *GB; _Float16* LOGF; const float* rstd1; const float* lb;
    __device__ __forceinline__ void operator()(const AccT& acc, const Unit& u, int wr, int wc, int fr, int fq, LAS unsigned char*) const {
        const int pn = u.pn;
        const int rbase = u.row0 + wr * 64 + fr, cw = wc * 32 + 8 * fq;
#pragma unroll
        for (int ai = 0; ai < 2; ++ai)
#pragma unroll
            for (int m = 0; m < 4; ++m) {
                const int row = rbase + ai * 128 + m * 16; const float rs = rstd1[row];
                if (pn >= 2 && pn < 6) {
                    const float r2 = rs * rs;
                    f32x4 v0 = acc[ai][0][m][0] * acc[ai][1][m][0] * r2, v1 = acc[ai][0][m][1] * acc[ai][1][m][1] * r2;
                    store8_bf16(U + (size_t)row * 512 + (pn - 2) * 128 + cw, v0, v1);
                } else {
#pragma unroll
                    for (int bj = 0; bj < 2; ++bj) {
                        const int col = pn * 256 + bj * 128 + cw;
                        f32x4 z0 = acc[ai][bj][m][0] * rs, z1 = acc[ai][bj][m][1] * rs;
                        if (pn < 2) { store8_bf16(CB + (size_t)row * 512 + col, z0, z1); }
                        else if (pn < 8) {
#pragma unroll
                            for (int j = 0; j < 4; ++j) { z0[j] = z0[j] * sigmoidf_(z0[j]); z1[j] = z1[j] * sigmoidf_(z1[j]); }
                            store8_bf16(Q + (size_t)row * 512 + (col - 1536), z0, z1);
                        } else if (pn < 10) {
                            const int c = col - 2048; const f32x4 l0 = *(const f32x4*)(lb + c), l1 = *(const f32x4*)(lb + c + 4);
                            f16x8 o;
#pragma unroll
                            for (int j = 0; j < 4; ++j) { o[j] = (_Float16)__logf(l0[j] + (1.0f - l0[j]) * sigmoidf_(z0[j])); o[4 + j] = (_Float16)__logf(l1[j] + (1.0f - l1[j]) * sigmoidf_(z1[j])); }
                            *(f16x8*)(LOGF + (size_t)row * 512 + c) = o;
                        } else if (pn < 12) { store8_bf16(V + (size_t)row * 512 + (col - 2560), z0, z1); }
                        else if (pn < 14) {
#pragma unroll
                            for (int j = 0; j < 4; ++j) { z0[j] = z0[j] * sigmoidf_(z0[j]); z1[j] = z1[j] * sigmoidf_(z1[j]); }
                            store8_bf16(G + (size_t)row * 512 + (col - 3072), z0, z1);
                        } else {
#pragma unroll
                            for (int j = 0; j < 4; ++j) { z0[j] = sigmoidf_(z0[j]); z1[j] = sigmoidf_(z1[j]); }
                            if (pn < 18) store8_bf16(GA + (size_t)row * 1024 + (col - 3584), z0, z1);
                            else store8_bf16(GB + (size_t)row * 1024 + (col - 4608), z0, z1);
                        }
                    }
                }
            }
    }
};
struct EpiMemKV {
    static constexpr bool PERM = false;
    float *outk, *outv; bf16_t *KB, *VT;
    __device__ __forceinline__ void operator()(const AccT& acc, const Unit& u, int wr, int wc, int fr, int fq, LAS unsigned char*) const {
        const int rbase = u.row0 + wr * 64 + fr;
#pragma unroll
        for (int ai = 0; ai < 2; ++ai)
#pragma unroll
            for (int m = 0; m < 4; ++m) {
                const int row = rbase + ai * 128 + m * 16;
#pragma unroll
                for (int bj = 0; bj < 2; ++bj)
#pragma unroll
                    for (int n = 0; n < 2; ++n) {
                        const int col = u.pn * 256 + bj * 128 + wc * 32 + n * 16 + 4 * fq; const f32x4 v = acc[ai][bj][m][n];
                        if (col < 1024) { *(f32x4*)(outk + (size_t)row * 1024 + col) = v; u32x2 w; w.x = cvt_pk_bf16(v[0], v[1]); w.y = cvt_pk_bf16(v[2], v[3]); *(u32x2*)(KB + (size_t)row * 1024 + col) = w; }
                        else { const int c = col - 1024; *(f32x4*)(outv + (size_t)row * 1024 + c) = v;
                            const int b = row >> 8, key = row & 255, h = c >> 8, d = c & 255; bf16_t* vp = VT + (((size_t)b * 4 + h) * 256 + d) * 256 + key;
#pragma unroll
                            for (int j = 0; j < 4; ++j) vp[j * 256] = f2bf(v[j]); }
                    }
            }
    }
};
struct EpiYA {
    static constexpr bool PERM = true;
    bf16_t* GA;
    __device__ __forceinline__ void operator()(const AccT& acc, const Unit& u, int wr, int wc, int fr, int fq, LAS unsigned char*) const {
        const int rbase = u.row0 + wr * 64 + fr, cw = u.pn * 256 + wc * 32 + 8 * fq;
#pragma unroll
        for (int ai = 0; ai < 2; ++ai)
#pragma unroll
            for (int m = 0; m < 4; ++m)
#pragma unroll
                for (int bj = 0; bj < 2; ++bj) { bf16_t* p = GA + (size_t)(rbase + ai * 128 + m * 16) * 1024 + cw + bj * 128; f32x4 g0, g1; load8_bf16(p, g0, g1);
                    store8_bf16(p, g0 * acc[ai][bj][m][0], g1 * acc[ai][bj][m][1]); }
    }
};
struct EpiMerge {
    static constexpr bool PERM = true;
    bf16_t* YA; const bf16_t* GB;
    __device__ __forceinline__ void operator()(const AccT& acc, const Unit& u, int wr, int wc, int fr, int fq, LAS unsigned char*) const {
        const int rbase = u.row0 + wr * 64 + fr, cw = u.pn * 256 + wc * 32 + 8 * fq;
#pragma unroll
        for (int ai = 0; ai < 2; ++ai)
#pragma unroll
            for (int m = 0; m < 4; ++m)
#pragma unroll
                for (int bj = 0; bj < 2; ++bj) { const size_t o = (size_t)(rbase + ai * 128 + m * 16) * 1024 + cw + bj * 128; f32x4 y0, y1, g0, g1; load8_bf16(YA + o, y0, y1); load8_bf16(GB + o, g0, g1);
                    store8_bf16(YA + o, y0 + g0 * acc[ai][bj][m][0], y1 + g1 * acc[ai][bj][m][1]); }
    }
};
struct EpiRes {
    static constexpr bool PERM = true;
    const bf16_t* base; bf16_t* out; float* ss;
    __device__ __forceinline__ void operator()(const AccT& acc, const Unit& u, int wr, int wc, int fr, int fq, LAS unsigned char*) const {
        const int rbase = u.row0 + wr * 64 + fr, cw = u.pn * 256 + wc * 32 + 8 * fq;
#pragma unroll
        for (int ai = 0; ai < 2; ++ai)
#pragma unroll
            for (int m = 0; m < 4; ++m) { const int row = rbase + ai * 128 + m * 16; float s = 0.f;
#pragma unroll
                for (int bj = 0; bj < 2; ++bj) { const size_t o = (size_t)row * 1024 + cw + bj * 128; f32x4 b0, b1; load8_bf16(base + o, b0, b1);
                    const f32x4 x0 = b0 + acc[ai][bj][m][0], x1 = b1 + acc[ai][bj][m][1];
                    s += (x0[0] * x0[0] + x0[1] * x0[1]) + (x0[2] * x0[2] + x0[3] * x0[3]) + (x1[0] * x1[0] + x1[1] * x1[1]) + (x1[2] * x1[2] + x1[3] * x1[3]);
                    store8_bf16(out + o, x0, x1); }
                s += __shfl_xor(s, 16); s += __shfl_xor(s, 32);
                if (fq == 0) ss[(size_t)row * 16 + u.pn * 4 + wc] = s; }
    }
};
template <bool RELU2, int LDO> struct EpiScaleRow {
    static constexpr bool PERM = true;
    bf16_t* out; const float* ss;
    __device__ __forceinline__ void operator()(const AccT& acc, const Unit& u, int wr, int wc, int fr, int fq, LAS unsigned char*) const {
        const int rbase = u.row0 + wr * 64 + fr, cw = u.pn * 256 + wc * 32 + 8 * fq;
#pragma unroll
        for (int ai = 0; ai < 2; ++ai)
#pragma unroll
            for (int m = 0; m < 4; ++m) { const int row = rbase + ai * 128 + m * 16; const float rs = rsqrtf(sum16(ss + (size_t)row * 16) * (1.0f / 1024.0f) + EPS);
#pragma unroll
                for (int bj = 0; bj < 2; ++bj) { f32x4 z0 = acc[ai][bj][m][0] * rs, z1 = acc[ai][bj][m][1] * rs;
                    if (RELU2) {
#pragma unroll
                        for (int j = 0; j < 4; ++j) { const float a = fmaxf(z0[j], 0.f), b = fmaxf(z1[j], 0.f); z0[j] = a * a; z1[j] = b * b; } }
                    store8_bf16(out + (size_t)row * LDO + cw + bj * 128, z0, z1); } }
    }
};
struct EpiSoftmax {
    static constexpr bool PERM = true;
    bf16_t* P; float* lsum;
    __device__ __forceinline__ void operator()(const AccT& acc, const Unit& u, int wr, int wc, int fr, int fq, LAS unsigned char* xl) const {
        LAS float* XM = (LAS float*)xl;
        float mx[2][4];
#pragma unroll
        for (int ai = 0; ai < 2; ++ai)
#pragma unroll
            for (int m = 0; m < 4; ++m) { float v = -3.0e38f;
#pragma unroll
                for (int bj = 0; bj < 2; ++bj)
#pragma unroll
                    for (int n = 0; n < 2; ++n)
#pragma unroll
                        for (int j = 0; j < 4; ++j) v = fmaxf(v, acc[ai][bj][m][n][j]);
                v = fmaxf(v, __shfl_xor(v, 16)); v = fmaxf(v, __shfl_xor(v, 32));
                if (fq == 0) XM[(ai * 128 + wr * 64 + m * 16 + fr) * 4 + wc] = v; }
        asm volatile("s_waitcnt lgkmcnt(0)" ::: "memory"); __builtin_amdgcn_s_barrier(); asm volatile("" ::: "memory");
#pragma unroll
        for (int ai = 0; ai < 2; ++ai)
#pragma unroll
            for (int m = 0; m < 4; ++m) { const f32x4 t = *(const LAS f32x4*)(XM + (ai * 128 + wr * 64 + m * 16 + fr) * 4); mx[ai][m] = fmaxf(fmaxf(t[0], t[1]), fmaxf(t[2], t[3])); }
        const int cw = wc * 32 + 8 * fq;
#pragma unroll
        for (int ai = 0; ai < 2; ++ai)
#pragma unroll
            for (int m = 0; m < 4; ++m) { const int rl = ai * 128 + wr * 64 + m * 16 + fr; const size_t row = (size_t)u.row0 + rl; float s = 0.f;
#pragma unroll
                for (int bj = 0; bj < 2; ++bj) { u32x4 w; float e[8];
#pragma unroll
                    for (int j = 0; j < 4; ++j) { e[j] = __expf(acc[ai][bj][m][0][j] - mx[ai][m]); e[4 + j] = __expf(acc[ai][bj][m][1][j] - mx[ai][m]); }
                    w.x = cvt_pk_bf16(e[0], e[1]); w.y = cvt_pk_bf16(e[2], e[3]); w.z = cvt_pk_bf16(e[4], e[5]); w.w = cvt_pk_bf16(e[6], e[7]);
                    s += (bf_lo(w.x) + bf_hi(w.x)) + (bf_lo(w.y) + bf_hi(w.y)) + (bf_lo(w.z) + bf_hi(w.z)) + (bf_lo(w.w) + bf_hi(w.w));
                    if (rl < u.nv) *(u32x4*)(P + row * 1024 + u.h * 256 + bj * 128 + cw) = w; }
                s += __shfl_xor(s, 16); s += __shfl_xor(s, 32);
                if (fq == 0 && rl < u.nv) lsum[(row * 4 + u.h) * 4 + wc] = s; }
    }
};
struct EpiPV {
    static constexpr bool PERM = true;
    bf16_t* AO; const float* lsum;
    __device__ __forceinline__ void operator()(const AccT& acc, const Unit& u, int wr, int wc, int fr, int fq, LAS unsigned char*) const {
        const int cw = wc * 32 + 8 * fq;
#pragma unroll
        for (int ai = 0; ai < 2; ++ai)
#pragma unroll
            for (int m = 0; m < 4; ++m) { const int rl = ai * 128 + wr * 64 + m * 16 + fr; const size_t row = (size_t)u.row0 + rl;
                if (rl < u.nv) { const f32x4 l4 = *(const f32x4*)(lsum + (row * 4 + u.h) * 4); const float inv = 1.0f / ((l4[0] + l4[1]) + (l4[2] + l4[3]));
#pragma unroll
                    for (int bj = 0; bj < 2; ++bj) store8_bf16(AO + row * 1024 + u.h * 256 + bj * 128 + cw, acc[ai][bj][m][0] * inv, acc[ai][bj][m][1] * inv); } }
    }
};

__device__ __forceinline__ void transpose_tile(LAS float* T, const float* src, int src_ld, bf16_t* dst, int dst_ld, int k0, const float* gain, float scale) {
    const int tid = threadIdx.x;
    { const int i = tid >> 4, j4 = (tid & 15) * 4;
#pragma unroll
      for (int p = 0; p < 2; ++p) { const int ii = i + p * 32; const f32x4 v = *(const f32x4*)(src + (size_t)(k0 + ii) * src_ld + j4); const float gsc = (gain ? gain[k0 + ii] : 1.0f) * scale;
          T[ii * 65 + j4] = v[0] * gsc; T[ii * 65 + j4 + 1] = v[1] * gsc; T[ii * 65 + j4 + 2] = v[2] * gsc; T[ii * 65 + j4 + 3] = v[3] * gsc; } }
    __syncthreads();
    { const int n = tid >> 3, kg = tid & 7; u32x4 w;
      w.x = cvt_pk_bf16(T[(kg * 8 + 0) * 65 + n], T[(kg * 8 + 1) * 65 + n]); w.y = cvt_pk_bf16(T[(kg * 8 + 2) * 65 + n], T[(kg * 8 + 3) * 65 + n]);
      w.z = cvt_pk_bf16(T[(kg * 8 + 4) * 65 + n], T[(kg * 8 + 5) * 65 + n]); w.w = cvt_pk_bf16(T[(kg * 8 + 6) * 65 + n], T[(kg * 8 + 7) * 65 + n]);
      *(u32x4*)(dst + (size_t)n * dst_ld + k0 + kg * 8) = w; }
    __syncthreads();
}
__device__ __forceinline__ int win_rowmap(int n) {
    if (n < 512 || n >= 1536) return n;
    if (n < 1024) { const int j = (n - 512) >> 7; return 512 + (2 * j) * 128 + ((n - 512) & 127); }
    const int j = (n - 1024) >> 7; return 512 + (2 * j + 1) * 128 + ((n - 1024) & 127);
}
__device__ void prepass(const Params& p, LAS unsigned char* lds) {
    unsigned char* ws = p.ws; const int tid = threadIdx.x, G = gridDim.x, bx = blockIdx.x;
    const int gt = bx * NTHREADS + tid, GT = G * NTHREADS;
    { float* lb = (float*)(ws + OFF_LB); const float* hl = p.in[10]; for (int i = gt; i < 512; i += GT) lb[i] = sigmoidf_(hl[i] - hl[512 + i]); }
    { const int wv = gt >> 6, lane = tid & 63, NW = GT >> 6;
      bf16_t* XB = (bf16_t*)(ws + OFF_XB); float* rstd1 = (float*)(ws + OFF_RSTD1); bf16_t* MEMB = (bf16_t*)(ws + OFF_MEMB);
      for (int r = wv; r < NTOK + 1024; r += NW) {
          const float* src = r < NP ? p.in[0] + (size_t)r * 1024 : (r < NTOK ? p.in[1] + (size_t)(r - NP) * 1024 : p.in[2] + (size_t)(r - NTOK) * 1024);
          f32x4 v[4]; float s = 0.f;
#pragma unroll
          for (int i = 0; i < 4; ++i) { v[i] = *(const f32x4*)(src + i * 256 + lane * 4); s += (v[i][0] * v[i][0] + v[i][1] * v[i][1]) + (v[i][2] * v[i][2] + v[i][3] * v[i][3]); }
#pragma unroll
          for (int o = 32; o >= 1; o >>= 1) s += __shfl_xor(s, o);
          const float rs = rsqrtf(s * (1.0f / 1024.0f) + EPS);
          if (r < NTOK) { if (lane == 0) rstd1[r] = rs;
#pragma unroll
              for (int i = 0; i < 4; ++i) { u32x2 w; w.x = cvt_pk_bf16(v[i][0], v[i][1]); w.y = cvt_pk_bf16(v[i][2], v[i][3]); *(u32x2*)(XB + (size_t)r * 1024 + i * 256 + lane * 4) = w; } }
          else { const float* gm = p.in[16];
#pragma unroll
              for (int i = 0; i < 4; ++i) { const f32x4 g4 = *(const f32x4*)(gm + i * 256 + lane * 4); u32x2 w; w.x = cvt_pk_bf16(v[i][0] * rs * g4[0], v[i][1] * rs * g4[1]); w.y = cvt_pk_bf16(v[i][2] * rs * g4[2], v[i][3] * rs * g4[3]);
                  *(u32x2*)(MEMB + (size_t)(r - NTOK) * 1024 + i * 256 + lane * 4) = w; } }
      } }
    { const float* ck = p.in[5]; bf16_t* KBs = (bf16_t*)(ws + OFF_KB) + (size_t)4 * 256 * 1024;
      for (int i = gt; i < 16 * 256 * 1024 / 8; i += GT) { const f32x4 a = *(const f32x4*)(ck + (size_t)i * 8), b = *(const f32x4*)(ck + (size_t)i * 8 + 4); store8_bf16(KBs + (size_t)i * 8, a, b); } }
    { LAS float* T = (LAS float*)lds;
      for (int t = bx; t < 6016; t += G) {
          const float* src; int src_ld, dst_ld, kt, nt_; bf16_t* dst; const float* gain = nullptr; float scale = 1.f; int tt = t; int job;
          if (tt < 1408) job = 0; else if ((tt -= 1408) < 128) job = 1; else if ((tt -= 128) < 128) job = 2; else if ((tt -= 128) < 256) job = 3; else if ((tt -= 256) < 256) job = 4;
          else if ((tt -= 256) < 256) job = 5; else if ((tt -= 256) < 256) job = 6; else if ((tt -= 256) < 256) job = 7; else if ((tt -= 256) < 1024) job = 8; else if ((tt -= 1024) < 1024) job = 9; else { tt -= 1024; job = 10; }
          switch (job) {
              case 0: src = p.in[8]; src_ld = 5632; dst = (bf16_t*)(ws + OFF_WIN); dst_ld = 1024; kt = 16; gain = p.in[7]; break;
              case 1: src = p.in[12]; src_ld = 1024; dst = (bf16_t*)(ws + OFF_WCONV); dst_ld = 512; kt = 8; break;
              case 2: src = p.in[13]; src_ld = 1024; dst = (bf16_t*)(ws + OFF_WHG); dst_ld = 512; kt = 8; break;
              case 3: src = p.in[14]; src_ld = 1024; dst = (bf16_t*)(ws + OFF_WO); dst_ld = 1024; kt = 16; break;
              case 4: src = p.in[17]; src_ld = 1024; dst = (bf16_t*)(ws + OFF_WXQ); dst_ld = 1024; kt = 16; gain = p.in[15]; scale = 0.0625f; break;
              case 5: src = p.in[18]; src_ld = 1024; dst = (bf16_t*)(ws + OFF_WXKV); dst_ld = 1024; kt = 16; break;
              case 6: src = p.in[19]; src_ld = 1024; dst = (bf16_t*)(ws + OFF_WXKV) + (size_t)1024 * 1024; dst_ld = 1024; kt = 16; break;
              case 7: src = p.in[20]; src_ld = 1024; dst = (bf16_t*)(ws + OFF_WXO); dst_ld = 1024; kt = 16; break;
              case 8: src = p.in[22]; src_ld = 4096; dst = (bf16_t*)(ws + OFF_WUP); dst_ld = 1024; kt = 16; gain = p.in[21]; break;
              case 9: src = p.in[23]; src_ld = 1024; dst = (bf16_t*)(ws + OFF_WDOWN); dst_ld = 4096; kt = 64; break;
              default: { const int bh = tt >> 4; tt &= 15; const int sb = bh >> 2, h = bh & 3;
                         src = p.in[6] + (size_t)sb * 256 * 1024 + h * 256; src_ld = 1024; dst = (bf16_t*)(ws + OFF_VT) + ((size_t)(4 + sb) * 4 + h) * 65536; dst_ld = 256; kt = 4; break; }
          }
          const int ki = tt % kt, ni = tt / kt; const int n0 = ni * 64; const int drow = (job == 0) ? win_rowmap(n0) : n0;
          (void)nt_;
          transpose_tile(T, src + n0, src_ld, dst + (size_t)drow * dst_ld, dst_ld, ki * 64, gain, scale);
      } }
}

__device__ void conv_phase(const Params& p) {
    unsigned char* ar = p.ws + OFF_ARENA; bf16_t* CB = (bf16_t*)(ar + AR_CB); const bf16_t* U = (const bf16_t*)(ar + AR_U);
    const float* cw = p.in[9]; const float* sc = p.in[3];
    const int gt = blockIdx.x * NTHREADS + threadIdx.x, GT = gridDim.x * NTHREADS;
    for (int idx = gt; idx < NTOK * 64; idx += GT) {
        const int row = idx >> 6, c8 = (idx & 63) * 8;
        int t, T, sb = 0; const bool samp = row >= NP;
        if (!samp) { t = row & 8191; T = 8192; } else { t = (row - NP) & 15; sb = (row - NP) >> 4; T = 16; }
        f32x4 u0a, u0b, u1a, u1b, u2a, u2b;
        load8_bf16(U + (size_t)row * 512 + c8, u0a, u0b);
        if (t >= 1) load8_bf16(U + (size_t)(row - 1) * 512 + c8, u1a, u1b);
        else if (samp) { u1a = *(const f32x4*)(sc + ((size_t)sb * 2 + 1) * 512 + c8); u1b = *(const f32x4*)(sc + ((size_t)sb * 2 + 1) * 512 + c8 + 4); }
        else { u1a = (f32x4){0.f, 0.f, 0.f, 0.f}; u1b = u1a; }
        if (t >= 2) load8_bf16(U + (size_t)(row - 2) * 512 + c8, u2a, u2b);
        else if (samp) { const int pr = t;
            u2a = *(const f32x4*)(sc + ((size_t)sb * 2 + pr) * 512 + c8); u2b = *(const f32x4*)(sc + ((size_t)sb * 2 + pr) * 512 + c8 + 4); }
        else { u2a = (f32x4){0.f, 0.f, 0.f, 0.f}; u2b = u2a; }
        const f32x4 w0a = *(const f32x4*)(cw + c8), w0b = *(const f32x4*)(cw + c8 + 4), w1a = *(const f32x4*)(cw + 512 + c8), w1b = *(const f32x4*)(cw + 512 + c8 + 4),
                    w2a = *(const f32x4*)(cw + 1024 + c8), w2b = *(const f32x4*)(cw + 1024 + c8 + 4);
        f32x4 ca, cb; load8_bf16(CB + (size_t)row * 512 + c8, ca, cb);
        const f32x4 ya = u2a * w0a + u1a * w1a + u0a * w2a, yb = u2b * w0b + u1b * w1b + u0b * w2b;
        store8_bf16(CB + (size_t)row * 512 + c8, ca * ya, cb * yb);
        if (t >= T - 2) { float* o = samp ? p.out + OUT_CONVS + ((size_t)sb * 2 + (t - (T - 2))) * 512 + c8 : p.out + OUT_CONVP + ((size_t)(row >> 13) * 2 + (t - (T - 2))) * 512 + c8;
            *(f32x4*)o = u0a; *(f32x4*)(o + 4) = u0b; }
    }
}

__device__ __forceinline__ void chunk_unit(int cu, int& row0, int& nvalid, int& h) {
    if (cu < 2048) { const int seq = cu >> 7, c = cu & 127; h = seq & 3; row0 = (seq >> 2) * 8192 + c * 64; nvalid = 64; }
    else { const int s = cu - 2048; h = s & 3; row0 = NP + (s >> 2) * 16; nvalid = 16; }
}
__device__ void hgrn_pass1(const Params& p, LAS unsigned char* lds) {
    unsigned char* ar = p.ws + OFF_ARENA; const _Float16* LOGF = (const _Float16*)(ar + AR_LOGF); const bf16_t* V = (const bf16_t*)(ar + AR_V);
    bf16_t* ST = (bf16_t*)p.out; float* DEC = (float*)(p.ws + OFF_DEC);
    const int tid = threadIdx.x, k = tid & 127, seg = tid >> 7, t0 = seg * 16;
    const int wid = tid >> 6, lane = tid & 63, fr = lane & 15, fq = lane >> 4;
    LAS float* SEGT = (LAS float*)lds; LAS bf16_t* KdT = (LAS bf16_t*)(lds + 2048); LAS bf16_t* VTl = (LAS bf16_t*)(lds + 2048 + 18432);
    for (int cu = blockIdx.x; cu < NCHUNK_UNITS; cu += gridDim.x) {
        int row0, nvalid, h; chunk_unit(cu, row0, nvalid, h);
        float lf[16], bc[16]; float run = 0.f;
#pragma unroll
        for (int i = 0; i < 16; ++i) { const int t = t0 + i; lf[i] = (t < nvalid) ? (float)LOGF[(size_t)(row0 + t) * 512 + h * 128 + k] : 0.f; run += lf[i]; bc[i] = run; }
        SEGT[seg * 128 + k] = run;
        __syncthreads();
        float off = 0.f, tot = 0.f;
#pragma unroll
        for (int s = 0; s < 4; ++s) { const float x = SEGT[s * 128 + k]; tot += x; if (s < seg) off += x; }
        unsigned pk[8];
#pragma unroll
        for (int i = 0; i < 16; i += 2) { const float k0 = (1.0f - __expf(lf[i])) * __expf(tot - (bc[i] + off)), k1 = (1.0f - __expf(lf[i + 1])) * __expf(tot - (bc[i + 1] + off)); pk[i >> 1] = cvt_pk_bf16(k0, k1); }
        *(LAS u32x4*)(KdT + k * 72 + t0) = (u32x4){pk[0], pk[1], pk[2], pk[3]}; *(LAS u32x4*)(KdT + k * 72 + t0 + 8) = (u32x4){pk[4], pk[5], pk[6], pk[7]};
#pragma unroll
        for (int i = 0; i < 16; i += 2) { const int t = t0 + i; const unsigned a = (t < nvalid) ? V[(size_t)(row0 + t) * 512 + h * 128 + k] : 0u, b = (t + 1 < nvalid) ? V[(size_t)(row0 + t + 1) * 512 + h * 128 + k] : 0u; pk[i >> 1] = a | (b << 16); }
        *(LAS u32x4*)(VTl + k * 72 + t0) = (u32x4){pk[0], pk[1], pk[2], pk[3]}; *(LAS u32x4*)(VTl + k * 72 + t0 + 8) = (u32x4){pk[4], pk[5], pk[6], pk[7]};
        if (seg == 0) DEC[(size_t)cu * 128 + k] = __expf(tot);
        __syncthreads();
        const int vb = (wid >> 1) * 32, kb = (wid & 1) * 64;
        f32x4 acc[2][4];
#pragma unroll
        for (int i = 0; i < 2; ++i)
#pragma unroll
            for (int j = 0; j < 4; ++j) acc[i][j] = (f32x4){0.f, 0.f, 0.f, 0.f};
#pragma unroll
        for (int ks = 0; ks < 2; ++ks) { bf16x8 af[2], bfr[4];
#pragma unroll
            for (int i = 0; i < 2; ++i) af[i] = *(const LAS bf16x8*)(VTl + (vb + 16 * i + fr) * 72 + ks * 32 + fq * 8);
#pragma unroll
            for (int j = 0; j < 4; ++j) bfr[j] = *(const LAS bf16x8*)(KdT + (kb + 16 * j + fr) * 72 + ks * 32 + fq * 8);
#pragma unroll
            for (int i = 0; i < 2; ++i)
#pragma unroll
                for (int j = 0; j < 4; ++j) acc[i][j] = __builtin_amdgcn_mfma_f32_16x16x32_bf16(bfr[j], af[i], acc[i][j], 0, 0, 0); }
#pragma unroll
        for (int i = 0; i < 2; ++i)
#pragma unroll
            for (int j = 0; j < 4; ++j) { u32x2 w; w.x = cvt_pk_bf16(acc[i][j][0], acc[i][j][1]); w.y = cvt_pk_bf16(acc[i][j][2], acc[i][j][3]);
                *(u32x2*)(ST + (size_t)cu * 16384 + (vb + 16 * i + fr) * 128 + kb + 16 * j + 4 * fq) = w; }
        __syncthreads();
    }
}
__device__ void hgrn_scan(const Params& p) {
    unsigned* ST = (unsigned*)p.out; const float* DEC = (const float*)(p.ws + OFF_DEC);
    float* out_hp = p.out + OUT_HGP; float* out_hs = p.out + OUT_HGS; const float* sh = p.in[4];
    const int gt = blockIdx.x * NTHREADS + threadIdx.x, GT = gridDim.x * NTHREADS;
    for (int task = gt; task < 16 * 8192; task += GT) {
        const int seq = task >> 13, pi = task & 8191, v = pi >> 6, k = (pi & 63) * 2;
        unsigned* stp = ST + ((size_t)seq * 128 * 16384 + v * 128 + k) / 2;
        const float* dp = DEC + (size_t)seq * 128 * 128 + k;
        float s0 = 0.f, s1 = 0.f;
        for (int c0 = 0; c0 < 128; c0 += 8) {
            unsigned kv[8]; float d0[8], d1[8];
#pragma unroll
            for (int j = 0; j < 8; ++j) { kv[j] = stp[(size_t)(c0 + j) * 8192]; d0[j] = dp[(c0 + j) * 128]; d1[j] = dp[(c0 + j) * 128 + 1]; }
#pragma unroll
            for (int j = 0; j < 8; ++j) { stp[(size_t)(c0 + j) * 8192] = cvt_pk_bf16(s0, s1); s0 = d0[j] * s0 + bf_lo(kv[j]); s1 = d1[j] * s1 + bf_hi(kv[j]); }
        }
        out_hp[(size_t)seq * 16384 + k * 128 + v] = s0; out_hp[(size_t)seq * 16384 + (k + 1) * 128 + v] = s1;
    }
    for (int task = gt; task < 64 * 8192; task += GT) {
        const int j = task >> 13, pi = task & 8191, v = pi >> 6, k = (pi & 63) * 2;
        unsigned* stp = ST + ((size_t)(2048 + j) * 16384 + v * 128 + k) / 2;
        const float* dp = DEC + (size_t)(2048 + j) * 128 + k;
        float s0 = sh[(size_t)j * 16384 + k * 128 + v], s1 = sh[(size_t)j * 16384 + (k + 1) * 128 + v];
        const unsigned kv = stp[0]; stp[0] = cvt_pk_bf16(s0, s1);
        s0 = dp[0] * s0 + bf_lo(kv); s1 = dp[1] * s1 + bf_hi(kv);
        out_hs[(size_t)j * 16384 + k * 128 + v] = s0; out_hs[(size_t)j * 16384 + (k + 1) * 128 + v] = s1;
    }
}
__device__ void hgrn_pass3(const Params& p, LAS unsigned char* lds) {
    unsigned char* ar = p.ws + OFF_ARENA; const _Float16* LOGF = (const _Float16*)(ar + AR_LOGF); const bf16_t* Q = (const bf16_t*)(ar + AR_Q); const bf16_t* V = (const bf16_t*)(ar + AR_V);
    bf16_t* Gt = (bf16_t*)(ar + AR_G); const bf16_t* ST = (const bf16_t*)p.out; const float* hgn = p.in[11];
    const int tid = threadIdx.x, k = tid & 127, seg = tid >> 7, t0 = seg * 16;
    const int wid = tid >> 6, lane = tid & 63, fr = lane & 15, fq = lane >> 4;
    LAS float* SEGT = (LAS float*)lds; LAS float* RS = (LAS float*)(lds + 2048);
    LAS bf16_t* QD = (LAS bf16_t*)(lds + 4096); LAS bf16_t* KI = (LAS bf16_t*)(lds + 4096 + 17408); LAS bf16_t* VTl = (LAS bf16_t*)(lds + 4096 + 2 * 17408);
    LAS bf16_t* SC = (LAS bf16_t*)(lds + 4096 + 2 * 17408 + 18432); LAS bf16_t* STt = (LAS bf16_t*)(lds + 4096 + 2 * 17408 + 18432 + 9216);
    for (int cu = blockIdx.x; cu < NCHUNK_UNITS; cu += gridDim.x) {
        int row0, nvalid, h; chunk_unit(cu, row0, nvalid, h);
        float lf[16], bc[16]; float run = 0.f;
#pragma unroll
        for (int i = 0; i < 16; ++i) { const int t = t0 + i; lf[i] = (t < nvalid) ? (float)LOGF[(size_t)(row0 + t) * 512 + h * 128 + k] : 0.f; run += lf[i]; bc[i] = run; }
        SEGT[seg * 128 + k] = run;
#pragma unroll
        for (int q = 0; q < 4; ++q) { const int idx = tid + q * 512, v = idx >> 4, kc = (idx & 15) * 8; *(LAS u32x4*)(STt + v * 136 + kc) = *(const u32x4*)(ST + (size_t)cu * 16384 + v * 128 + kc); }
        __syncthreads();
        float off = 0.f;
#pragma unroll
        for (int s = 0; s < 4; ++s) { const float x = SEGT[s * 128 + k]; if (s < seg) off += x; }
#pragma unroll
        for (int i = 0; i < 16; ++i) { const int t = t0 + i; const float b = bc[i] + off; const float qv = (t < nvalid) ? bf2f(Q[(size_t)(row0 + t) * 512 + h * 128 + k]) : 0.f;
            QD[t * 136 + k] = f2bf(qv * __expf(b)); KI[t * 136 + k] = f2bf((1.0f - __expf(lf[i])) * __expf(fminf(-b, 80.f))); }
        unsigned pk[8];
#pragma unroll
        for (int i = 0; i < 16; i += 2) { const int t = t0 + i; const unsigned a = (t < nvalid) ? V[(size_t)(row0 + t) * 512 + h * 128 + k] : 0u, b = (t + 1 < nvalid) ? V[(size_t)(row0 + t + 1) * 512 + h * 128 + k] : 0u; pk[i >> 1] = a | (b << 16); }
        *(LAS u32x4*)(VTl + k * 72 + t0) = (u32x4){pk[0], pk[1], pk[2], pk[3]}; *(LAS u32x4*)(VTl + k * 72 + t0 + 8) = (u32x4){pk[4], pk[5], pk[6], pk[7]};
        __syncthreads();
        const int tt = wid & 3;
#pragma unroll
        for (int sti = 0; sti < 2; ++sti) { const int st = (wid >> 2) * 2 + sti; f32x4 a = (f32x4){0.f, 0.f, 0.f, 0.f};
            if (st <= tt) {
#pragma unroll
                for (int ks = 0; ks < 4; ++ks) { const bf16x8 bfr = *(const LAS bf16x8*)(KI + (st * 16 + fr) * 136 + ks * 32 + fq * 8), af = *(const LAS bf16x8*)(QD + (tt * 16 + fr) * 136 + ks * 32 + fq * 8);
                    a = __builtin_amdgcn_mfma_f32_16x16x32_bf16(bfr, af, a, 0, 0, 0); } }
            const int t = tt * 16 + fr, s = st * 16 + 4 * fq;
#pragma unroll
            for (int j = 0; j < 4; ++j) if (s + j > t) a[j] = 0.f;
            u32x2 w; w.x = cvt_pk_bf16(a[0], a[1]); w.y = cvt_pk_bf16(a[2], a[3]); *(LAS u32x2*)(SC + t * 72 + s) = w; }
        __syncthreads();
        const int vt0 = (wid >> 2) * 4;
        f32x4 o[4];
#pragma unroll
        for (int vi = 0; vi < 4; ++vi) o[vi] = (f32x4){0.f, 0.f, 0.f, 0.f};
#pragma unroll
        for (int ks = 0; ks < 2; ++ks) { const bf16x8 af = *(const LAS bf16x8*)(SC + (tt * 16 + fr) * 72 + ks * 32 + fq * 8);
#pragma unroll
            for (int vi = 0; vi < 4; ++vi) { const bf16x8 bfr = *(const LAS bf16x8*)(VTl + ((vt0 + vi) * 16 + fr) * 72 + ks * 32 + fq * 8); o[vi] = __builtin_amdgcn_mfma_f32_16x16x32_bf16(bfr, af, o[vi], 0, 0, 0); } }
#pragma unroll
        for (int ks = 0; ks < 4; ++ks) { const bf16x8 af = *(const LAS bf16x8*)(QD + (tt * 16 + fr) * 136 + ks * 32 + fq * 8);
#pragma unroll
            for (int vi = 0; vi < 4; ++vi) { const bf16x8 bfr = *(const LAS bf16x8*)(STt + ((vt0 + vi) * 16 + fr) * 136 + ks * 32 + fq * 8); o[vi] = __builtin_amdgcn_mfma_f32_16x16x32_bf16(bfr, af, o[vi], 0, 0, 0); } }
        float ss = 0.f;
#pragma unroll
        for (int vi = 0; vi < 4; ++vi) ss += (o[vi][0] * o[vi][0] + o[vi][1] * o[vi][1]) + (o[vi][2] * o[vi][2] + o[vi][3] * o[vi][3]);
        ss += __shfl_xor(ss, 16); ss += __shfl_xor(ss, 32);
        const int t = tt * 16 + fr;
        if (fq == 0) RS[t * 2 + (wid >> 2)] = ss;
        __syncthreads();
        const float rstd = rsqrtf((RS[t * 2] + RS[t * 2 + 1]) * (1.0f / 128.0f) + EPS);
        if (t < nvalid) {
#pragma unroll
            for (int vi = 0; vi < 4; ++vi) { const int v = (vt0 + vi) * 16 + 4 * fq; bf16_t* gp = Gt + (size_t)(row0 + t) * 512 + h * 128 + v;
                const u32x2 gw = *(const u32x2*)gp; const f32x4 nm = *(const f32x4*)(hgn + v);
                u32x2 w; w.x = cvt_pk_bf16(o[vi][0] * rstd * nm[0] * bf_lo(gw.x), o[vi][1] * rstd * nm[1] * bf_hi(gw.x)); w.y = cvt_pk_bf16(o[vi][2] * rstd * nm[2] * bf_lo(gw.y), o[vi][3] * rstd * nm[3] * bf_hi(gw.y));
                *(u32x2*)gp = w; } }
        __syncthreads();
    }
}
__device__ void final_phase(const Params& p) {
    const bf16_t* X = (const bf16_t*)(p.ws + OFF_ARENA + AR_X2B); const float* ss = (const float*)(p.ws + OFF_SS4); const float* g = p.in[24];
    const int gt = blockIdx.x * NTHREADS + threadIdx.x, GT = gridDim.x * NTHREADS;
    for (int idx = gt; idx < NTOK * 128; idx += GT) {
        const int row = idx >> 7, c8 = (idx & 127) * 8; f32x4 a, b; load8_bf16(X + (size_t)row * 1024 + c8, a, b);
        const float rs = rsqrtf(sum16(ss + (size_t)row * 16) * (1.0f / 1024.0f) + EPS); const f32x4 g0 = *(const f32x4*)(g + c8), g1 = *(const f32x4*)(g + c8 + 4);
        float* o = p.out + OUT_Y + (size_t)row * 1024 + c8; *(f32x4*)o = a * rs * g0; *(f32x4*)(o + 4) = b * rs * g1;
    }
}

#ifndef STOP_AFTER
#define STOP_AFTER 0
#endif
__global__ void __launch_bounds__(NTHREADS, 2) fwd_megakernel(Params p) {
    extern __shared__ __attribute__((aligned(16))) unsigned char lds_raw[];
    LAS unsigned char* lds = (LAS unsigned char*)lds_raw;
    cg::grid_group grid = cg::this_grid();
    unsigned char* ws = p.ws; unsigned char* ar = ws + OFF_ARENA;
    const int G = gridDim.x, bx = blockIdx.x;

    prepass(p, lds);
    grid.sync();
    if (STOP_AFTER == 1) return;
    {
        pg8::Gemm g{(const bf16_t*)(ws + OFF_XB), (const bf16_t*)(ws + OFF_WIN), 1024, 1024, 1024}; pg8::StaticOrder S; S.init(g, NTOK, 5632, G, bx);
        EpiProj E{(bf16_t*)(ar + AR_CB), (bf16_t*)(ar + AR_U), (bf16_t*)(ar + AR_Q), (bf16_t*)(ar + AR_V), (bf16_t*)(ar + AR_G), (bf16_t*)(ar + AR_GA), (bf16_t*)(ar + AR_GB), (_Float16*)(ar + AR_LOGF),
                  (const float*)(ws + OFF_RSTD1), (const float*)(ws + OFF_LB)};
        pg8::gemm_phase(lds, g, S, E);
        pg8::Gemm g2{(const bf16_t*)(ws + OFF_MEMB), (const bf16_t*)(ws + OFF_WXKV), 1024, 1024, 1024}; pg8::StaticOrder S2; S2.init(g2, 1024, 2048, G, (bx + G / 2) % G);
        EpiMemKV E2{p.out + OUT_MEMK, p.out + OUT_MEMV, (bf16_t*)(ws + OFF_KB), (bf16_t*)(ws + OFF_VT)};
        pg8::gemm_phase(lds, g2, S2, E2);
    }
    grid.sync();
    if (STOP_AFTER == 2) return;
    conv_phase(p);
#ifndef SKIP_PASS1
    hgrn_pass1(p, lds);
#else
    { const u32x4* src = (const u32x4*)(ar + 4 * SZ_S); u32x4* dst = (u32x4*)p.out; const size_t n = 4 * SZ_S / 16;
      for (size_t i = (size_t)bx * NTHREADS + threadIdx.x; i < n; i += (size_t)G * NTHREADS) dst[i] = src[i]; }
#endif
    grid.sync();
    if (STOP_AFTER == 3) return;
    hgrn_scan(p);
    grid.sync();
    if (STOP_AFTER == 4) return;
    hgrn_pass3(p, lds);
    grid.sync();
    if (STOP_AFTER == 5) return;
    {
        pg8::Gemm g{(const bf16_t*)(ar + AR_CB), (const bf16_t*)(ws + OFF_WCONV), 512, 512, 512}; pg8::StaticOrder S; S.init(g, NTOK, 1024, G, bx);
        EpiYA E{(bf16_t*)(ar + AR_GA)};
        pg8::gemm_phase(lds, g, S, E);
        pg8::Gemm g2{(const bf16_t*)(ar + AR_G), (const bf16_t*)(ws + OFF_WHG), 512, 512, 512}; pg8::StaticOrder S2; S2.init(g2, NTOK, 1024, G, bx);
        EpiMerge E2{(bf16_t*)(ar + AR_GA), (const bf16_t*)(ar + AR_GB)};
        pg8::gemm_phase(lds, g2, S2, E2);
    }
    grid.sync();
    if (STOP_AFTER == 6) return;
    {
        pg8::Gemm g{(const bf16_t*)(ar + AR_GA), (const bf16_t*)(ws + OFF_WO), 1024, 1024, 1024}; pg8::StaticOrder S; S.init(g, NTOK, 1024, G, bx);
        EpiRes E{(const bf16_t*)(ws + OFF_XB), (bf16_t*)(ar + AR_X1B), (float*)(ws + OFF_SS2)};
        pg8::gemm_phase(lds, g, S, E);
    }
    grid.sync();
    if (STOP_AFTER == 7) return;
    {
        pg8::Gemm g{(const bf16_t*)(ar + AR_X1B), (const bf16_t*)(ws + OFF_WXQ), 1024, 1024, 1024}; pg8::StaticOrder S; S.init(g, NTOK, 1024, G, bx);
        EpiScaleRow<false, 1024> E{(bf16_t*)(ar + AR_QB), (const float*)(ws + OFF_SS2)};
        pg8::gemm_phase(lds, g, S, E);
    }
    grid.sync();
    if (STOP_AFTER == 8) return;
    {
        pg8::Gemm g{(const bf16_t*)(ar + AR_QB), (const bf16_t*)(ws + OFF_KB), 1024, 1024, 256}; pg8::AttnOrder S{G, bx, g.A, g.Bt, 0};
        EpiSoftmax E{(bf16_t*)(ar + AR_P), (float*)(ws + OFF_LSUM)};
        pg8::gemm_phase(lds, g, S, E);
    }
    grid.sync();
    if (STOP_AFTER == 9) return;
    {
        pg8::Gemm g{(const bf16_t*)(ar + AR_P), (const bf16_t*)(ws + OFF_VT), 1024, 256, 256}; pg8::AttnOrder S{G, bx, g.A, g.Bt, 1};
        EpiPV E{(bf16_t*)(ar + AR_AO), (const float*)(ws + OFF_LSUM)};
        pg8::gemm_phase(lds, g, S, E);
    }
    grid.sync();
    if (STOP_AFTER == 10) return;
    {
        pg8::Gemm g{(const bf16_t*)(ar + AR_AO), (const bf16_t*)(ws + OFF_WXO), 1024, 1024, 1024}; pg8::StaticOrder S; S.init(g, NTOK, 1024, G, bx);
        EpiRes E{(const bf16_t*)(ar + AR_X1B), (bf16_t*)(ar + AR_X2B), (float*)(ws + OFF_SS3)};
        pg8::gemm_phase(lds, g, S, E);
    }
    grid.sync();
    if (STOP_AFTER == 11) return;
    {
        pg8::Gemm g{(const bf16_t*)(ar + AR_X2B), (const bf16_t*)(ws + OFF_WUP), 1024, 1024, 1024}; pg8::StaticOrder S; S.init(g, NTOK, 4096, G, bx);
        EpiScaleRow<true, 4096> E{(bf16_t*)(ar + AR_HID), (const float*)(ws + OFF_SS3)};
        pg8::gemm_phase(lds, g, S, E);
    }
    grid.sync();
    if (STOP_AFTER == 12) return;
    {
        pg8::Gemm g{(const bf16_t*)(ar + AR_HID), (const bf16_t*)(ws + OFF_WDOWN), 4096, 4096, 4096}; pg8::StaticOrder S; S.init(g, NTOK, 1024, G, bx);
        EpiRes E{(const bf16_t*)(ar + AR_X2B), (bf16_t*)(ar + AR_X2B), (float*)(ws + OFF_SS4)};
        pg8::gemm_phase(lds, g, S, E);
    }
    grid.sync();
    if (STOP_AFTER == 13) return;
    final_phase(p);
}

extern "C" void kernel_launch(void* const* d_in, const int* in_sizes, int n_in, void* d_out, int out_size, void* d_ws, size_t ws_size, hipStream_t stream) {
    static int grid_blocks = 0;
    if (grid_blocks == 0) {
        if (n_in != 25 || ws_size < WS_END) { fprintf(stderr, "kernel_launch: unexpected inputs (n_in %d, ws %zu, need %zu)\n", n_in, ws_size, (size_t)WS_END); grid_blocks = -1; return; }
        int dev = 0, cus = 0, per_cu = 0;
        hipGetDevice(&dev); hipDeviceGetAttribute(&cus, hipDeviceAttributeMultiprocessorCount, dev);
        if (hipFuncSetAttribute((const void*)fwd_megakernel, hipFuncAttributeMaxDynamicSharedMemorySize, LDS_BYTES) != hipSuccess) { fprintf(stderr, "kernel_launch: hipFuncSetAttribute failed\n"); grid_blocks = -1; return; }
        if (hipOccupancyMaxActiveBlocksPerMultiprocessor(&per_cu, (const void*)fwd_megakernel, NTHREADS, LDS_BYTES) != hipSuccess || per_cu < 1) { fprintf(stderr, "kernel_launch: occupancy query gives %d\n", per_cu); per_cu = 1; }
        (void)hipGetLastError();
        grid_blocks = cus * 1;
    }
    if (grid_blocks < 0) return;
    Params p{};
    for (int i = 0; i < 25; ++i) p.in[i] = (const float*)d_in[i];
    p.out = (float*)d_out; p.ws = (unsigned char*)d_ws;
    void* args[] = {&p};
    hipError_t e = hipLaunchCooperativeKernel((const void*)fwd_megakernel, dim3(grid_blocks), dim3(NTHREADS), args, LDS_BYTES, stream);
    if (e != hipSuccess) fprintf(stderr, "cooperative launch failed: %s (grid %d)\n", hipGetErrorString(e), grid_blocks);
}
```

```cpp
#include <hip/hip_runtime.h>
#include <hip/hip_cooperative_groups.h>
#include <cstdio>
namespace cg = cooperative_groups;

#define LAS __attribute__((address_space(3)))
typedef unsigned short bf16_t;
typedef short bf16x8 __attribute__((ext_vector_type(8)));
typedef float f32x4 __attribute__((ext_vector_type(4)));
typedef unsigned u32x4 __attribute__((ext_vector_type(4)));
typedef unsigned u32x2 __attribute__((ext_vector_type(2)));
typedef _Float16 f16x8 __attribute__((ext_vector_type(8)));

constexpr int DM = 1024, NP = 32768, NS = 256, NTOK = NP + NS, NTOKP = NTOK + 256;
constexpr int NCHUNK_UNITS = 2048 + 64;
constexpr float EPS = 1e-6f;
constexpr int NTHREADS = 512;
constexpr int STAGE_LDS = 131072, EXTRA_LDS = 8192, LDS_BYTES = STAGE_LDS + EXTRA_LDS;

constexpr size_t SZ_S = (size_t)NTOK * 512 * 2;
constexpr size_t OFF_WIN = 0;
constexpr size_t OFF_WCONV = OFF_WIN + (size_t)5632 * 1024 * 2;
constexpr size_t OFF_WHG = OFF_WCONV + (size_t)1024 * 512 * 2;
constexpr size_t OFF_WO = OFF_WHG + (size_t)1024 * 512 * 2;
constexpr size_t OFF_WXQ = OFF_WO + (size_t)1024 * 1024 * 2;
constexpr size_t OFF_WXKV = OFF_WXQ + (size_t)1024 * 1024 * 2;
constexpr size_t OFF_WXO = OFF_WXKV + (size_t)2048 * 1024 * 2;
constexpr size_t OFF_WUP = OFF_WXO + (size_t)1024 * 1024 * 2;
constexpr size_t OFF_WDOWN = OFF_WUP + (size_t)4096 * 1024 * 2;
constexpr size_t OFF_KB = OFF_WDOWN + (size_t)1024 * 4096 * 2;
constexpr size_t OFF_VT = OFF_KB + (size_t)20 * 256 * 1024 * 2;
constexpr size_t OFF_MEMB = OFF_VT + (size_t)20 * 256 * 1024 * 2;
constexpr size_t OFF_LB = OFF_MEMB + (size_t)1024 * 1024 * 2;
constexpr size_t OFF_RSTD1 = OFF_LB + 2048;
constexpr size_t OFF_SS2 = OFF_RSTD1 + (size_t)NTOKP * 4;
constexpr size_t OFF_SS3 = OFF_SS2 + (size_t)NTOKP * 16 * 4;
constexpr size_t OFF_SS4 = OFF_SS3 + (size_t)NTOKP * 16 * 4;
constexpr size_t OFF_LSUM = OFF_SS4 + (size_t)NTOKP * 16 * 4;
constexpr size_t OFF_DEC = OFF_LSUM + (size_t)NTOKP * 16 * 4;
constexpr size_t OFF_XB = OFF_DEC + (size_t)NCHUNK_UNITS * 128 * 4;
constexpr size_t OFF_ARENA = OFF_XB + (size_t)NTOK * 1024 * 2;
constexpr size_t WS_END = OFF_ARENA + 10 * SZ_S + (1u << 20);
constexpr size_t AR_CB = 0, AR_U = SZ_S, AR_Q = 2 * SZ_S, AR_LOGF = 3 * SZ_S, AR_V = 4 * SZ_S, AR_G = 5 * SZ_S, AR_GA = 6 * SZ_S, AR_GB = 8 * SZ_S;
constexpr size_t AR_X1B = 0, AR_QB = 2 * SZ_S, AR_P = 6 * SZ_S, AR_AO = 2 * SZ_S, AR_X2B = 8 * SZ_S, AR_HID = 0;
constexpr size_t OUT_Y = 0;
constexpr size_t OUT_CONVP = (size_t)NTOK * 1024;
constexpr size_t OUT_HGP = OUT_CONVP + 4 * 2 * 512;
constexpr size_t OUT_MEMK = OUT_HGP + (size_t)4 * 4 * 16384;
constexpr size_t OUT_MEMV = OUT_MEMK + (size_t)4 * 256 * 1024;
constexpr size_t OUT_CONVS = OUT_MEMV + (size_t)4 * 256 * 1024;
constexpr size_t OUT_HGS = OUT_CONVS + 16 * 2 * 512;

struct Params { const float* in[25]; float* out; unsigned char* ws; };

typedef float f32x2_ __attribute__((ext_vector_type(2)));
typedef __bf16 bf16x2_ __attribute__((ext_vector_type(2)));
__device__ __forceinline__ unsigned cvt_pk_bf16(float lo, float hi) { const f32x2_ v = {lo, hi}; const bf16x2_ b = __builtin_convertvector(v, bf16x2_); return __builtin_bit_cast(unsigned, b); }
__device__ __forceinline__ bf16_t f2bf(float f) { return (bf16_t)(cvt_pk_bf16(f, 0.f) & 0xffffu); }
__device__ __forceinline__ float bf2f(bf16_t b) { return __uint_as_float(((unsigned)b) << 16); }
__device__ __forceinline__ float bf_lo(unsigned w) { return __uint_as_float(w << 16); }
__device__ __forceinline__ float bf_hi(unsigned w) { return __uint_as_float(w & 0xffff0000u); }
__device__ __forceinline__ float sigmoidf_(float z) { return __builtin_amdgcn_rcpf(1.0f + __expf(-z)); }
__device__ __forceinline__ void store8_bf16(bf16_t* p, f32x4 v0, f32x4 v1) {
    u32x4 w; w.x = cvt_pk_bf16(v0[0], v0[1]); w.y = cvt_pk_bf16(v0[2], v0[3]); w.z = cvt_pk_bf16(v1[0], v1[1]); w.w = cvt_pk_bf16(v1[2], v1[3]); *(u32x4*)p = w; }
__device__ __forceinline__ void load8_bf16(const bf16_t* p, f32x4& v0, f32x4& v1) {
    const u32x4 w = *(const u32x4*)p; v0[0] = bf_lo(w.x); v0[1] = bf_hi(w.x); v0[2] = bf_lo(w.y); v0[3] = bf_hi(w.y); v1[0] = bf_lo(w.z); v1[1] = bf_hi(w.z); v1[2] = bf_lo(w.w); v1[3] = bf_hi(w.w); }

__device__ __forceinline__ float sum16(const float* p) { const f32x4 a = *(const f32x4*)p, b = *(const f32x4*)(p + 4), c = *(const f32x4*)(p + 8), d = *(const f32x4*)(p + 12);
    return (((a[0] + a[1]) + (a[2] + a[3])) + ((b[0] + b[1]) + (b[2] + b[3]))) + (((c[0] + c[1]) + (c[2] + c[3])) + ((d[0] + d[1]) + (d[2] + d[3]))); }
namespace pg8 {
constexpr int BM = 256, BK = 64, HALF = 128, HTB = HALF * BK * 2, NXCD = 8, WGM = 8;
__device__ __forceinline__ int lds_byte(int r, int c) { const int st = (r >> 4) * 2 + (c >> 5), rr = r & 15, cc = c & 31, ob = rr * 64 + cc * 2; return st * 1024 + (ob ^ (((ob >> 9) & 1) << 5)); }
__device__ __forceinline__ void stage_rc(int b, int& R, int& C) { const int st = b / 1024, sb = b % 1024, swz = sb ^ (((sb >> 9) & 1) << 5); R = (st >> 1) * 16 + swz / 64; C = (st & 1) * 32 + (swz % 64) / 2; }
__device__ __forceinline__ int perm32(int rho) { const int n = rho >> 4, i = rho & 15; return 8 * (i >> 2) + 4 * n + (i & 3); }

struct Unit { int pm, pn, row0, h, batch, nv; };
struct Gemm { const bf16_t* A; const bf16_t* Bt; int lda, ldb, K; };

struct StaticOrder {
    int nM, nN, nwg, G, c; const bf16_t* A; const bf16_t* Bt; int lda, ldb;
    __device__ void init(const Gemm& g, int M, int N, int G_, int c_) { nM = M / BM; nN = N / BM; nwg = nM * nN; G = G_; c = c_; A = g.A; Bt = g.Bt; lda = g.lda; ldb = g.ldb; }
    __device__ bool next(int i, Unit& u) const {
        const long L = (long)i * G + c; if (L >= nwg) return false;
        int wgid = (int)L; { const int q = nwg / NXCD, r = nwg % NXCD, xcd = wgid % NXCD, off = wgid / NXCD; wgid = (xcd < r ? xcd * (q + 1) : r * (q + 1) + (xcd - r) * q) + off; }
        const int nig = WGM * nN, gid = wgid / nig, fm = gid * WGM, gsz = (nM - fm) < WGM ? (nM - fm) : WGM;
        u.pm = fm + ((wgid % nig) % gsz); u.pn = (wgid % nig) / gsz; u.row0 = u.pm * BM; u.h = 0; u.batch = 0; u.nv = 256; return true;
    }
    __device__ __forceinline__ const char* aptr(const Unit& u) const { return (const char*)A + (size_t)u.pm * 256 * lda * 2; }
    __device__ __forceinline__ const char* bptr(const Unit& u) const { return (const char*)Bt + (size_t)u.pn * 256 * ldb * 2; }
};
struct AttnOrder {
    int G, c; const bf16_t* A; const bf16_t* B; int mode;
    __device__ bool next(int i, Unit& u) const {
        const int L = i * G + c; if (L >= 576) return false;
        if (L < 512) { u.batch = L >> 7; u.h = (L >> 5) & 3; u.row0 = u.batch * 8192 + (L & 31) * 256; u.nv = 256; }
        else { const int s = L - 512; u.batch = 4 + (s >> 2); u.h = s & 3; u.row0 = NP + (s >> 2) * 16; u.nv = 16; }
        u.pm = 0; u.pn = 0; return true;
    }
    __device__ __forceinline__ const char* aptr(const Unit& u) const { return (const char*)(A + (size_t)u.row0 * 1024 + u.h * 256); }
    __device__ __forceinline__ const char* bptr(const Unit& u) const {
        return mode == 0 ? (const char*)(B + (size_t)u.batch * 256 * 1024 + u.h * 256) : (const char*)(B + ((size_t)u.batch * 4 + u.h) * 65536); }
};

template <class Epi, class Sched>
__device__ __forceinline__ void gemm_phase(LAS unsigned char* lds, const Gemm g, const Sched& S, const Epi& E) {
    int tid_ = threadIdx.x; asm volatile("" : "+v"(tid_));
    const int tid = tid_, wid = __builtin_amdgcn_readfirstlane(tid >> 6), lane = tid & 63, wr = wid >> 2, wc = wid & 3, fr = lane & 15, fq = lane >> 4;
    const int K = g.K, nt = K / BK;
    unsigned voffA[2], voffB[2];
#pragma unroll
    for (int i = 0; i < 2; ++i) { int R, C; stage_rc(tid * 16 + i * 8192, R, C); const int Rb = Epi::PERM ? ((R & ~31) + perm32(R & 31)) : R;
        voffA[i] = (unsigned)(R * g.lda + C) * 2u; voffB[i] = (unsigned)(Rb * g.ldb + C) * 2u; }
    const size_t kstep = (size_t)(BK * 2);
    const size_t hA = (size_t)HALF * g.lda * 2, hB = (size_t)HALF * g.ldb * 2;
    const unsigned ldsw = (unsigned)wid * 1024u;
    const int aoff = lds_byte(wr * 64 + fr, fq * 8), boff = lds_byte(wc * 32 + fr, fq * 8);
#define PG8_SA(b, h) (((b) * 2 + (h)) * HTB)
#define PG8_SB(b, h) ((4 + (b) * 2 + (h)) * HTB)
#define PG8_STAGE(bufoff, gbase, voff) do { _Pragma("unroll") for (int _i = 0; _i < 2; ++_i) \
        __builtin_amdgcn_global_load_lds((const unsigned*)((const char*)(gbase) + (voff)[_i]), (LAS unsigned*)(lds + (bufoff) + ldsw + _i * 8192), 16, 0, 0); } while (0)
#define PG8_LDA(dst, b, h) do { _Pragma("unroll") for (int m = 0; m < 4; ++m) _Pragma("unroll") for (int k = 0; k < 2; ++k) dst[m][k] = *(const LAS bf16x8*)(lds + PG8_SA(b, h) + aoff + m * 2048 + k * 1024); } while (0)
#define PG8_LDB(dst, b, h) do { _Pragma("unroll") for (int n = 0; n < 2; ++n) _Pragma("unroll") for (int k = 0; k < 2; ++k) dst[n][k] = *(const LAS bf16x8*)(lds + PG8_SB(b, h) + boff + n * 2048 + k * 1024); } while (0)
#define PG8_MMA(ai, bj, At, Bt) do { __builtin_amdgcn_s_setprio(1); _Pragma("unroll") for (int m = 0; m < 4; ++m) _Pragma("unroll") for (int n = 0; n < 2; ++n) _Pragma("unroll") for (int k = 0; k < 2; ++k) \
        acc[ai][bj][m][n] = __builtin_amdgcn_mfma_f32_16x16x32_bf16(Bt[n][k], At[m][k], acc[ai][bj][m][n], 0, 0, 0); __builtin_amdgcn_s_setprio(0); } while (0)
#define PG8_WAIT_V(n) asm volatile("s_waitcnt vmcnt(" #n ")" ::: "memory")
#define PG8_WAIT_L(n) asm volatile("s_waitcnt lgkmcnt(" #n ")" ::: "memory")
#define PG8_BAR __builtin_amdgcn_s_barrier()
#define PG8_SCHED __builtin_amdgcn_sched_barrier(0)
    Unit cur, nxt; int ui = 0;
    if (!S.next(0, cur)) return;
    f32x4 acc[2][2][4][2];
#pragma unroll
    for (int a = 0; a < 2; ++a)
#pragma unroll
        for (int b = 0; b < 2; ++b)
#pragma unroll
            for (int m = 0; m < 4; ++m)
#pragma unroll
                for (int n = 0; n < 2; ++n) acc[a][b][m][n] = (f32x4){0.f, 0.f, 0.f, 0.f};
    bf16x8 At[4][2], B0[2][2], B1[2][2];
    const char* cA = S.aptr(cur); const char* cB = S.bptr(cur);
    PG8_STAGE(PG8_SB(0, 0), cB, voffB); PG8_STAGE(PG8_SA(0, 0), cA, voffA); PG8_STAGE(PG8_SB(0, 1), cB + hB, voffB); PG8_STAGE(PG8_SA(0, 1), cA + hA, voffA);
    if (wr == 1) PG8_BAR;
    PG8_WAIT_V(4); PG8_BAR;
    PG8_STAGE(PG8_SB(1, 0), cB + kstep, voffB); PG8_STAGE(PG8_SA(1, 0), cA + kstep, voffA); PG8_STAGE(PG8_SB(1, 1), cB + hB + kstep, voffB);
    PG8_WAIT_V(6); PG8_BAR;
    for (;;) {
        const bool has_next = S.next(ui + 1, nxt);
        const char* nA = has_next ? S.aptr(nxt) : cA; const char* nB = has_next ? S.bptr(nxt) : cB;
#pragma clang loop unroll(disable)
        for (int t = 0; t < nt; t += 2) {
            const bool last = (t == nt - 2);
            const char* a1 = cA + (size_t)(t + 1) * kstep;
            const char* a2 = last ? nA : cA + (size_t)(t + 2) * kstep; const char* b2 = last ? nB : cB + (size_t)(t + 2) * kstep;
            const char* a3 = a2 + kstep; const char* b3 = b2 + kstep;
            PG8_LDB(B0, 0, 0); PG8_SCHED; PG8_LDA(At, 0, 0); PG8_STAGE(PG8_SA(1, 1), a1 + hA, voffA);
            PG8_WAIT_L(8); PG8_BAR; PG8_WAIT_L(0); PG8_MMA(0, 0, At, B0); PG8_BAR; PG8_SCHED;
            PG8_LDB(B1, 0, 1); PG8_STAGE(PG8_SB(0, 0), b2, voffB);
            PG8_BAR; PG8_WAIT_L(0); PG8_MMA(0, 1, At, B1); PG8_BAR;
            PG8_LDA(At, 0, 1); PG8_STAGE(PG8_SA(0, 0), a2, voffA);
            PG8_BAR; PG8_WAIT_L(0); PG8_MMA(1, 0, At, B0); PG8_BAR; PG8_SCHED;
            PG8_STAGE(PG8_SB(0, 1), b2 + hB, voffB);
            PG8_WAIT_V(6); PG8_BAR; PG8_MMA(1, 1, At, B1); PG8_BAR;
            PG8_LDB(B0, 1, 0); PG8_SCHED; PG8_LDA(At, 1, 0); PG8_STAGE(PG8_SA(0, 1), a2 + hA, voffA);
            PG8_WAIT_L(8); PG8_BAR; PG8_WAIT_L(0); PG8_MMA(0, 0, At, B0); PG8_BAR; PG8_SCHED;
            PG8_LDB(B1, 1, 1); PG8_STAGE(PG8_SB(1, 0), b3, voffB);
            PG8_BAR; PG8_WAIT_L(0); PG8_MMA(0, 1, At, B1); PG8_BAR;
            PG8_LDA(At, 1, 1); PG8_STAGE(PG8_SA(1, 0), a3, voffA);
            PG8_BAR; PG8_WAIT_L(0); PG8_MMA(1, 0, At, B0); PG8_BAR; PG8_SCHED;
            PG8_STAGE(PG8_SB(1, 1), b3 + hB, voffB);
            PG8_WAIT_V(6); PG8_BAR; PG8_MMA(1, 1, At, B1); PG8_BAR;
        }
        E(acc, cur, wr, wc, fr, fq, lds + STAGE_LDS);
        if (!has_next) break;
#pragma unroll
        for (int a = 0; a < 2; ++a)
#pragma unroll
            for (int b = 0; b < 2; ++b)
#pragma unroll
                for (int m = 0; m < 4; ++m)
#pragma unroll
                    for (int n = 0; n < 2; ++n) acc[a][b][m][n] = (f32x4){0.f, 0.f, 0.f, 0.f};
        cur = nxt; cA = nA; cB = nB; ++ui;
    }
    PG8_WAIT_V(0);
    if (wr == 0) PG8_BAR;
    PG8_BAR;
#undef PG8_SA
#undef PG8_SB
#undef PG8_STAGE
#undef PG8_LDA
#undef PG8_LDB
#undef PG8_MMA
#undef PG8_WAIT_V
#undef PG8_WAIT_L
#undef PG8_BAR
#undef PG8_SCHED
}
}
using pg8::Unit;
typedef f32x4 AccT[2][2][4][2];


struct EpiProj {
    static constexpr bool PERM = true;
    bf16_t *CB, *U, *Q, *V, *G, *GA, *GB; _Float16* LOGF; const float* rstd1; const float* lb;
    __device__ __forceinline__ void operator()(const AccT& acc, const Unit& u, int wr, int wc, int fr, int fq, LAS unsigned char*) const {
        const int pn = u.pn;
        const int rbase = u.row0 + wr * 64 + fr, cw = wc * 32 + 8 * fq;
        float rsv[2][4];
#pragma unroll
        for (int ai = 0; ai < 2; ++ai)
#pragma unroll
            for (int m = 0; m < 4; ++m) rsv[ai][m] = rstd1[rbase + ai * 128 + m * 16];
        f32x4 lbv[2][2];
        if (pn == 8 || pn == 9) {
#pragma unroll
            for (int bj = 0; bj < 2; ++bj) { lbv[bj][0] = *(const f32x4*)(lb + (pn - 8) * 256 + bj * 128 + cw); lbv[bj][1] = *(const f32x4*)(lb + (pn - 8) * 256 + bj * 128 + cw + 4); } }
#pragma unroll
        for (int ai = 0; ai < 2; ++ai)
#pragma unroll
            for (int m = 0; m < 4; ++m) {
                const int row = rbase + ai * 128 + m * 16; const float rs = rsv[ai][m];
                if (pn >= 2 && pn < 6) {
                    const float r2 = rs * rs;
                    f32x4 v0 = acc[ai][0][m][0] * acc[ai][1][m][0] * r2, v1 = acc[ai][0][m][1] * acc[ai][1][m][1] * r2;
                    store8_bf16(U + (size_t)row * 512 + (pn - 2) * 128 + cw, v0, v1);
                } else {
#pragma unroll
                    for (int bj = 0; bj < 2; ++bj) {
                        const int col = pn * 256 + bj * 128 + cw;
                        f32x4 z0 = acc[ai][bj][m][0] * rs, z1 = acc[ai][bj][m][1] * rs;
                        if (pn < 2) { store8_bf16(CB + (size_t)row * 512 + col, z0, z1); }
                        else if (pn < 8) {
#pragma unroll
                            for (int j = 0; j < 4; ++j) { z0[j] = z0[j] * sigmoidf_(z0[j]); z1[j] = z1[j] * sigmoidf_(z1[j]); }
                            store8_bf16(Q + (size_t)row * 512 + (col - 1536), z0, z1);
                        } else if (pn < 10) {
                            const int c = col - 2048; const f32x4 l0 = lbv[bj][0], l1 = lbv[bj][1];
                            f16x8 o;
#pragma unroll
                            for (int j = 0; j < 4; ++j) { o[j] = (_Float16)__logf(l0[j] + (1.0f - l0[j]) * sigmoidf_(z0[j])); o[4 + j] = (_Float16)__logf(l1[j] + (1.0f - l1[j]) * sigmoidf_(z1[j])); }
                            *(f16x8*)(LOGF + (size_t)row * 512 + c) = o;
                        } else if (pn < 12) { store8_bf16(V + (size_t)row * 512 + (col - 2560), z0, z1); }
                        else if (pn < 14) {
#pragma unroll
                            for (int j = 0; j < 4; ++j) { z0[j] = z0[j] * sigmoidf_(z0[j]); z1[j] = z1[j] * sigmoidf_(z1[j]); }
                            store8_bf16(G + (size_t)row * 512 + (col - 3072), z0, z1);
                        } else {
#pragma unroll
                            for (int j = 0; j < 4; ++j) { z0[j] = sigmoidf_(z0[j]); z1[j] = sigmoidf_(z1[j]); }
                            if (pn < 18) store8_bf16(GA + (size_t)row * 1024 + (col - 3584), z0, z1);
                            else store8_bf16(GB + (size_t)row * 1024 + (col - 4608), z0, z1);
                        }
                    }
                }
            }
    }
};
struct EpiMemKV {
    static constexpr bool PERM = false;
    float *outk, *outv; bf16_t *KB, *VT;
    __device__ __forceinline__ void operator()(const AccT& acc, const Unit& u, int wr, int wc, int fr, int fq, LAS unsigned char*) const {
        const int rbase = u.row0 + wr * 64 + fr;
#pragma unroll
        for (int ai = 0; ai < 2; ++ai)
#pragma unroll
            for (int m = 0; m < 4; ++m) {
                const int row = rbase + ai * 128 + m * 16;
#pragma unroll
                for (int bj = 0; bj < 2; ++bj)
#pragma unroll
                    for (int n = 0; n < 2; ++n) {
                        const int col = u.pn * 256 + bj * 128 + wc * 32 + n * 16 + 4 * fq; const f32x4 v = acc[ai][bj][m][n];
                        if (col < 1024) { *(f32x4*)(outk + (size_t)row * 1024 + col) = v; u32x2 w; w.x = cvt_pk_bf16(v[0], v[1]); w.y = cvt_pk_bf16(v[2], v[3]); *(u32x2*)(KB + (size_t)row * 1024 + col) = w; }
                        else { const int c = col - 1024; *(f32x4*)(outv + (size_t)row * 1024 + c) = v;
                            const int b = row >> 8, key = row & 255, h = c >> 8, d = c & 255; bf16_t* vp = VT + (((size_t)b * 4 + h) * 256 + d) * 256 + key;
#pragma unroll
                            for (int j = 0; j < 4; ++j) vp[j * 256] = f2bf(v[j]); }
                    }
            }
    }
};
__device__ __forceinline__ void unpack8(const u32x4 w, f32x4& v0, f32x4& v1) { v0[0] = bf_lo(w.x); v0[1] = bf_hi(w.x); v0[2] = bf_lo(w.y); v0[3] = bf_hi(w.y); v1[0] = bf_lo(w.z); v1[1] = bf_hi(w.z); v1[2] = bf_lo(w.w); v1[3] = bf_hi(w.w); }
struct EpiYA {
    static constexpr bool PERM = true;
    bf16_t* GA;
    __device__ __forceinline__ void operator()(const AccT& acc, const Unit& u, int wr, int wc, int fr, int fq, LAS unsigned char*) const {
        const int rbase = u.row0 + wr * 64 + fr, cw = u.pn * 256 + wc * 32 + 8 * fq;
#pragma unroll
        for (int ai = 0; ai < 2; ++ai) { u32x4 t[4][2];
#pragma unroll
            for (int m = 0; m < 4; ++m)
#pragma unroll
                for (int bj = 0; bj < 2; ++bj) t[m][bj] = *(const u32x4*)(GA + (size_t)(rbase + ai * 128 + m * 16) * 1024 + cw + bj * 128);
#pragma unroll
            for (int m = 0; m < 4; ++m)
#pragma unroll
                for (int bj = 0; bj < 2; ++bj) { f32x4 g0, g1; unpack8(t[m][bj], g0, g1); store8_bf16(GA + (size_t)(rbase + ai * 128 + m * 16) * 1024 + cw + bj * 128, g0 * acc[ai][bj][m][0], g1 * acc[ai][bj][m][1]); } }
    }
};
struct EpiMerge {
    static constexpr bool PERM = true;
    bf16_t* YA; const bf16_t* GB;
    __device__ __forceinline__ void operator()(const AccT& acc, const Unit& u, int wr, int wc, int fr, int fq, LAS unsigned char*) const {
        const int rbase = u.row0 + wr * 64 + fr, cw = u.pn * 256 + wc * 32 + 8 * fq;
#pragma unroll
        for (int ai = 0; ai < 2; ++ai) { u32x4 ty[4][2], tg[4][2];
#pragma unroll
            for (int m = 0; m < 4; ++m)
#pragma unroll
                for (int bj = 0; bj < 2; ++bj) { const size_t o = (size_t)(rbase + ai * 128 + m * 16) * 1024 + cw + bj * 128; ty[m][bj] = *(const u32x4*)(YA + o); tg[m][bj] = *(const u32x4*)(GB + o); }
#pragma unroll
            for (int m = 0; m < 4; ++m)
#pragma unroll
                for (int bj = 0; bj < 2; ++bj) { const size_t o = (size_t)(rbase + ai * 128 + m * 16) * 1024 + cw + bj * 128; f32x4 y0, y1, g0, g1; unpack8(ty[m][bj], y0, y1); unpack8(tg[m][bj], g0, g1);
                    store8_bf16(YA + o, y0 + g0 * acc[ai][bj][m][0], y1 + g1 * acc[ai][bj][m][1]); } }
    }
};
struct EpiRes {
    static constexpr bool PERM = true;
    const bf16_t* base; bf16_t* out; float* ss;
    __device__ __forceinline__ void operator()(const AccT& acc, const Unit& u, int wr, int wc, int fr, int fq, LAS unsigned char*) const {
        const int rbase = u.row0 + wr * 64 + fr, cw = u.pn * 256 + wc * 32 + 8 * fq;
#pragma unroll
        for (int ai = 0; ai < 2; ++ai) { u32x4 t[4][2];
#pragma unroll
            for (int m = 0; m < 4; ++m)
#pragma unroll
                for (int bj = 0; bj < 2; ++bj) t[m][bj] = *(const u32x4*)(base + (size_t)(rbase + ai * 128 + m * 16) * 1024 + cw + bj * 128);
#pragma unroll
            for (int m = 0; m < 4; ++m) { const int row = rbase + ai * 128 + m * 16; float s = 0.f;
#pragma unroll
                for (int bj = 0; bj < 2; ++bj) { const size_t o = (size_t)row * 1024 + cw + bj * 128; f32x4 b0, b1; unpack8(t[m][bj], b0, b1);
                    const f32x4 x0 = b0 + acc[ai][bj][m][0], x1 = b1 + acc[ai][bj][m][1];
                    s += (x0[0] * x0[0] + x0[1] * x0[1]) + (x0[2] * x0[2] + x0[3] * x0[3]) + (x1[0] * x1[0] + x1[1] * x1[1]) + (x1[2] * x1[2] + x1[3] * x1[3]);
                    store8_bf16(out + o, x0, x1); }
                s += __shfl_xor(s, 16); s += __shfl_xor(s, 32);
                if (fq == 0) ss[(size_t)row * 16 + u.pn * 4 + wc] = s; } }
    }
};
template <bool RELU2, int LDO> struct EpiScaleRow {
    static constexpr bool PERM = true;
    bf16_t* out; const float* ss;
    __device__ __forceinline__ void operator()(const AccT& acc, const Unit& u, int wr, int wc, int fr, int fq, LAS unsigned char*) const {
        const int rbase = u.row0 + wr * 64 + fr, cw = u.pn * 256 + wc * 32 + 8 * fq;
#pragma unroll
        for (int ai = 0; ai < 2; ++ai) { f32x4 t[4][4]; float rs[4];
#pragma unroll
            for (int m = 0; m < 4; ++m)
#pragma unroll
                for (int q = 0; q < 4; ++q) t[m][q] = *(const f32x4*)(ss + (size_t)(rbase + ai * 128 + m * 16) * 16 + q * 4);
#pragma unroll
            for (int m = 0; m < 4; ++m) { const f32x4 a = t[m][0], b = t[m][1], c = t[m][2], d = t[m][3];
                rs[m] = rsqrtf(((((a[0] + a[1]) + (a[2] + a[3])) + ((b[0] + b[1]) + (b[2] + b[3]))) + (((c[0] + c[1]) + (c[2] + c[3])) + ((d[0] + d[1]) + (d[2] + d[3])))) * (1.0f / 1024.0f) + EPS); }
#pragma unroll
            for (int m = 0; m < 4; ++m) { const int row = rbase + ai * 128 + m * 16;
#pragma unroll
                for (int bj = 0; bj < 2; ++bj) { f32x4 z0 = acc[ai][bj][m][0] * rs[m], z1 = acc[ai][bj][m][1] * rs[m];
                    if (RELU2) {
#pragma unroll
                        for (int j = 0; j < 4; ++j) { const float a = fmaxf(z0[j], 0.f), b = fmaxf(z1[j], 0.f); z0[j] = a * a; z1[j] = b * b; } }
                    store8_bf16(out + (size_t)row * LDO + cw + bj * 128, z0, z1); } } }
    }
};
struct EpiSoftmax {
    static constexpr bool PERM = true;
    bf16_t* P; float* lsum;
    __device__ __forceinline__ void operator()(const AccT& acc, const Unit& u, int wr, int wc, int fr, int fq, LAS unsigned char* xl) const {
        LAS float* XM = (LAS float*)xl;
        float mx[2][4];
#pragma unroll
        for (int ai = 0; ai < 2; ++ai)
#pragma unroll
            for (int m = 0; m < 4; ++m) { float v = -3.0e38f;
#pragma unroll
                for (int bj = 0; bj < 2; ++bj)
#pragma unroll
                    for (int n = 0; n < 2; ++n)
#pragma unroll
                        for (int j = 0; j < 4; ++j) v = fmaxf(v, acc[ai][bj][m][n][j]);
                v = fmaxf(v, __shfl_xor(v, 16)); v = fmaxf(v, __shfl_xor(v, 32));
                if (fq == 0) XM[(ai * 128 + wr * 64 + m * 16 + fr) * 4 + wc] = v; }
        asm volatile("s_waitcnt lgkmcnt(0)" ::: "memory"); __builtin_amdgcn_s_barrier(); asm volatile("" ::: "memory");
#pragma unroll
        for (int ai = 0; ai < 2; ++ai)
#pragma unroll
            for (int m = 0; m < 4; ++m) { const f32x4 t = *(const LAS f32x4*)(XM + (ai * 128 + wr * 64 + m * 16 + fr) * 4); mx[ai][m] = fmaxf(fmaxf(t[0], t[1]), fmaxf(t[2], t[3])); }
        const int cw = wc * 32 + 8 * fq;
#pragma unroll
        for (int ai = 0; ai < 2; ++ai)
#pragma unroll
            for (int m = 0; m < 4; ++m) { const int rl = ai * 128 + wr * 64 + m * 16 + fr; const size_t row = (size_t)u.row0 + rl; float s = 0.f;
#pragma unroll
                for (int bj = 0; bj < 2; ++bj) { u32x4 w; float e[8];
#pragma unroll
                    for (int j = 0; j < 4; ++j) { e[j] = __expf(acc[ai][bj][m][0][j] - mx[ai][m]); e[4 + j] = __expf(acc[ai][bj][m][1][j] - mx[ai][m]); }
                    w.x = cvt_pk_bf16(e[0], e[1]); w.y = cvt_pk_bf16(e[2], e[3]); w.z = cvt_pk_bf16(e[4], e[5]); w.w = cvt_pk_bf16(e[6], e[7]);
                    s += (bf_lo(w.x) + bf_hi(w.x)) + (bf_lo(w.y) + bf_hi(w.y)) + (bf_lo(w.z) + bf_hi(w.z)) + (bf_lo(w.w) + bf_hi(w.w));
                    if (rl < u.nv) *(u32x4*)(P + row * 1024 + u.h * 256 + bj * 128 + cw) = w; }
                s += __shfl_xor(s, 16); s += __shfl_xor(s, 32);
                if (fq == 0 && rl < u.nv) lsum[(row * 4 + u.h) * 4 + wc] = s; }
    }
};
struct EpiPV {
    static constexpr bool PERM = true;
    bf16_t* AO; const float* lsum;
    __device__ __forceinline__ void operator()(const AccT& acc, const Unit& u, int wr, int wc, int fr, int fq, LAS unsigned char*) const {
        const int cw = wc * 32 + 8 * fq;
        f32x4 l4[2][4];
#pragma unroll
        for (int ai = 0; ai < 2; ++ai)
#pragma unroll
            for (int m = 0; m < 4; ++m) { const int rl = ai * 128 + wr * 64 + m * 16 + fr; l4[ai][m] = (rl < u.nv) ? *(const f32x4*)(lsum + (((size_t)u.row0 + rl) * 4 + u.h) * 4) : (f32x4){1.f, 1.f, 1.f, 1.f}; }
#pragma unroll
        for (int ai = 0; ai < 2; ++ai)
#pragma unroll
            for (int m = 0; m < 4; ++m) { const int rl = ai * 128 + wr * 64 + m * 16 + fr; const size_t row = (size_t)u.row0 + rl;
                if (rl < u.nv) { const float inv = 1.0f / ((l4[ai][m][0] + l4[ai][m][1]) + (l4[ai][m][2] + l4[ai][m][3]));
#pragma unroll
                    for (int bj = 0; bj < 2; ++bj) store8_bf16(AO + row * 1024 + u.h * 256 + bj * 128 + cw, acc[ai][bj][m][0] * inv, acc[ai][bj][m][1] * inv); } }
    }
};

__device__ __forceinline__ void transpose_tile(LAS float* T, const float* src, int src_ld, bf16_t* dst, int dst_ld, int k0, const float* gain, float scale) {
    const int tid = threadIdx.x;
    { const int i = tid >> 4, j4 = (tid & 15) * 4;
#pragma unroll
      for (int p = 0; p < 2; ++p) { const int ii = i + p * 32; const f32x4 v = *(const f32x4*)(src + (size_t)(k0 + ii) * src_ld + j4); const float gsc = (gain ? gain[k0 + ii] : 1.0f) * scale;
          T[ii * 65 + j4] = v[0] * gsc; T[ii * 65 + j4 + 1] = v[1] * gsc; T[ii * 65 + j4 + 2] = v[2] * gsc; T[ii * 65 + j4 + 3] = v[3] * gsc; } }
    __syncthreads();
    { const int n = tid >> 3, kg = tid & 7; u32x4 w;
      w.x = cvt_pk_bf16(T[(kg * 8 + 0) * 65 + n], T[(kg * 8 + 1) * 65 + n]); w.y = cvt_pk_bf16(T[(kg * 8 + 2) * 65 + n], T[(kg * 8 + 3) * 65 + n]);
      w.z = cvt_pk_bf16(T[(kg * 8 + 4) * 65 + n], T[(kg * 8 + 5) * 65 + n]); w.w = cvt_pk_bf16(T[(kg * 8 + 6) * 65 + n], T[(kg * 8 + 7) * 65 + n]);
      *(u32x4*)(dst + (size_t)n * dst_ld + k0 + kg * 8) = w; }
    __syncthreads();
}
__device__ __forceinline__ int win_rowmap(int n) {
    if (n < 512 || n >= 1536) return n;
    if (n < 1024) { const int j = (n - 512) >> 7; return 512 + (2 * j) * 128 + ((n - 512) & 127); }
    const int j = (n - 1024) >> 7; return 512 + (2 * j + 1) * 128 + ((n - 1024) & 127);
}
__device__ __forceinline__ void prepass(const Params& p, LAS unsigned char* lds) {
    unsigned char* ws = p.ws; const int tid = threadIdx.x, G = gridDim.x, bx = blockIdx.x;
    const int gt = bx * NTHREADS + tid, GT = G * NTHREADS;
    { float* lb = (float*)(ws + OFF_LB); const float* hl = p.in[10]; for (int i = gt; i < 512; i += GT) lb[i] = sigmoidf_(hl[i] - hl[512 + i]); }
    { const int wv = gt >> 6, lane = tid & 63, NW = GT >> 6;
      bf16_t* XB = (bf16_t*)(ws + OFF_XB); float* rstd1 = (float*)(ws + OFF_RSTD1); bf16_t* MEMB = (bf16_t*)(ws + OFF_MEMB);
      for (int r = wv; r < NTOK + 1024; r += NW) {
          const float* src = r < NP ? p.in[0] + (size_t)r * 1024 : (r < NTOK ? p.in[1] + (size_t)(r - NP) * 1024 : p.in[2] + (size_t)(r - NTOK) * 1024);
          f32x4 v[4]; float s = 0.f;
#pragma unroll
          for (int i = 0; i < 4; ++i) { v[i] = *(const f32x4*)(src + i * 256 + lane * 4); s += (v[i][0] * v[i][0] + v[i][1] * v[i][1]) + (v[i][2] * v[i][2] + v[i][3] * v[i][3]); }
#pragma unroll
          for (int o = 32; o >= 1; o >>= 1) s += __shfl_xor(s, o);
          const float rs = rsqrtf(s * (1.0f / 1024.0f) + EPS);
          if (r < NTOK) { if (lane == 0) rstd1[r] = rs;
#pragma unroll
              for (int i = 0; i < 4; ++i) { u32x2 w; w.x = cvt_pk_bf16(v[i][0], v[i][1]); w.y = cvt_pk_bf16(v[i][2], v[i][3]); *(u32x2*)(XB + (size_t)r * 1024 + i * 256 + lane * 4) = w; } }
          else { const float* gm = p.in[16];
#pragma unroll
              for (int i = 0; i < 4; ++i) { const f32x4 g4 = *(const f32x4*)(gm + i * 256 + lane * 4); u32x2 w; w.x = cvt_pk_bf16(v[i][0] * rs * g4[0], v[i][1] * rs * g4[1]); w.y = cvt_pk_bf16(v[i][2] * rs * g4[2], v[i][3] * rs * g4[3]);
                  *(u32x2*)(MEMB + (size_t)(r - NTOK) * 1024 + i * 256 + lane * 4) = w; } }
      } }
    { const float* ck = p.in[5]; bf16_t* KBs = (bf16_t*)(ws + OFF_KB) + (size_t)4 * 256 * 1024;
      for (int i = gt; i < 16 * 256 * 1024 / 8; i += GT) { const f32x4 a = *(const f32x4*)(ck + (size_t)i * 8), b = *(const f32x4*)(ck + (size_t)i * 8 + 4); store8_bf16(KBs + (size_t)i * 8, a, b); } }
    { LAS float* T = (LAS float*)lds;
      for (int t = bx; t < 6016; t += G) {
          const float* src; int src_ld, dst_ld, kt, nt_; bf16_t* dst; const float* gain = nullptr; float scale = 1.f; int tt = t; int job;
          if (tt < 1408) job = 0; else if ((tt -= 1408) < 128) job = 1; else if ((tt -= 128) < 128) job = 2; else if ((tt -= 128) < 256) job = 3; else if ((tt -= 256) < 256) job = 4;
          else if ((tt -= 256) < 256) job = 5; else if ((tt -= 256) < 256) job = 6; else if ((tt -= 256) < 256) job = 7; else if ((tt -= 256) < 1024) job = 8; else if ((tt -= 1024) < 1024) job = 9; else { tt -= 1024; job = 10; }
          switch (job) {
              case 0: src = p.in[8]; src_ld = 5632; dst = (bf16_t*)(ws + OFF_WIN); dst_ld = 1024; kt = 16; gain = p.in[7]; break;
              case 1: src = p.in[12]; src_ld = 1024; dst = (bf16_t*)(ws + OFF_WCONV); dst_ld = 512; kt = 8; break;
              case 2: src = p.in[13]; src_ld = 1024; dst = (bf16_t*)(ws + OFF_WHG); dst_ld = 512; kt = 8; break;
              case 3: src = p.in[14]; src_ld = 1024; dst = (bf16_t*)(ws + OFF_WO); dst_ld = 1024; kt = 16; break;
              case 4: src = p.in[17]; src_ld = 1024; dst = (bf16_t*)(ws + OFF_WXQ); dst_ld = 1024; kt = 16; gain = p.in[15]; scale = 0.0625f; break;
              case 5: src = p.in[18]; src_ld = 1024; dst = (bf16_t*)(ws + OFF_WXKV); dst_ld = 1024; kt = 16; break;
              case 6: src = p.in[19]; src_ld = 1024; dst = (bf16_t*)(ws + OFF_WXKV) + (size_t)1024 * 1024; dst_ld = 1024; kt = 16; break;
              case 7: src = p.in[20]; src_ld = 1024; dst = (bf16_t*)(ws + OFF_WXO); dst_ld = 1024; kt = 16; break;
              case 8: src = p.in[22]; src_ld = 4096; dst = (bf16_t*)(ws + OFF_WUP); dst_ld = 1024; kt = 16; gain = p.in[21]; break;
              case 9: src = p.in[23]; src_ld = 1024; dst = (bf16_t*)(ws + OFF_WDOWN); dst_ld = 4096; kt = 64; break;
              default: { const int bh = tt >> 4; tt &= 15; const int sb = bh >> 2, h = bh & 3;
                         src = p.in[6] + (size_t)sb * 256 * 1024 + h * 256; src_ld = 1024; dst = (bf16_t*)(ws + OFF_VT) + ((size_t)(4 + sb) * 4 + h) * 65536; dst_ld = 256; kt = 4; break; }
          }
          const int ki = tt % kt, ni = tt / kt; const int n0 = ni * 64; const int drow = (job == 0) ? win_rowmap(n0) : n0;
          (void)nt_;
          transpose_tile(T, src + n0, src_ld, dst + (size_t)drow * dst_ld, dst_ld, ki * 64, gain, scale);
      } }
}

__device__ __forceinline__ void conv_phase(const Params& p) {
    unsigned char* ar = p.ws + OFF_ARENA; bf16_t* CB = (bf16_t*)(ar + AR_CB); const bf16_t* U = (const bf16_t*)(ar + AR_U);
    const float* cw = p.in[9]; const float* sc = p.in[3];
    const int gt = blockIdx.x * NTHREADS + threadIdx.x, GT = gridDim.x * NTHREADS;
    for (int idx = gt; idx < NTOK * 64; idx += GT) {
        const int row = idx >> 6, c8 = (idx & 63) * 8;
        int t, T, sb = 0; const bool samp = row >= NP;
        if (!samp) { t = row & 8191; T = 8192; } else { t = (row - NP) & 15; sb = (row - NP) >> 4; T = 16; }
        f32x4 u0a, u0b, u1a, u1b, u2a, u2b;
        load8_bf16(U + (size_t)row * 512 + c8, u0a, u0b);
        if (t >= 1) load8_bf16(U + (size_t)(row - 1) * 512 + c8, u1a, u1b);
        else if (samp) { u1a = *(const f32x4*)(sc + ((size_t)sb * 2 + 1) * 512 + c8); u1b = *(const f32x4*)(sc + ((size_t)sb * 2 + 1) * 512 + c8 + 4); }
        else { u1a = (f32x4){0.f, 0.f, 0.f, 0.f}; u1b = u1a; }
        if (t >= 2) load8_bf16(U + (size_t)(row - 2) * 512 + c8, u2a, u2b);
        else if (samp) { const int pr = t;
            u2a = *(const f32x4*)(sc + ((size_t)sb * 2 + pr) * 512 + c8); u2b = *(const f32x4*)(sc + ((size_t)sb * 2 + pr) * 512 + c8 + 4); }
        else { u2a = (f32x4){0.f, 0.f, 0.f, 0.f}; u2b = u2a; }
        const f32x4 w0a = *(const f32x4*)(cw + c8), w0b = *(const f32x4*)(cw + c8 + 4), w1a = *(const f32x4*)(cw + 512 + c8), w1b = *(const f32x4*)(cw + 512 + c8 + 4),
                    w2a = *(const f32x4*)(cw + 1024 + c8), w2b = *(const f32x4*)(cw + 1024 + c8 + 4);
        f32x4 ca, cb; load8_bf16(CB + (size_t)row * 512 + c8, ca, cb);
        const f32x4 ya = u2a * w0a + u1a * w1a + u0a * w2a, yb = u2b * w0b + u1b * w1b + u0b * w2b;
        store8_bf16(CB + (size_t)row * 512 + c8, ca * ya, cb * yb);
        if (t >= T - 2) { float* o = samp ? p.out + OUT_CONVS + ((size_t)sb * 2 + (t - (T - 2))) * 512 + c8 : p.out + OUT_CONVP + ((size_t)(row >> 13) * 2 + (t - (T - 2))) * 512 + c8;
            *(f32x4*)o = u0a; *(f32x4*)(o + 4) = u0b; }
    }
}

__device__ __forceinline__ void chunk_unit(int cu, int& row0, int& nvalid, int& h) {
    if (cu < 2048) { const int seq = cu >> 7, c = cu & 127; h = seq & 3; row0 = (seq >> 2) * 8192 + c * 64; nvalid = 64; }
    else { const int s = cu - 2048; h = s & 3; row0 = NP + (s >> 2) * 16; nvalid = 16; }
}
__device__ __forceinline__ void hgrn_pass1(const Params& p, LAS unsigned char* lds) {
    unsigned char* ar = p.ws + OFF_ARENA; const _Float16* LOGF = (const _Float16*)(ar + AR_LOGF); const bf16_t* V = (const bf16_t*)(ar + AR_V);
    bf16_t* ST = (bf16_t*)p.out; float* DEC = (float*)(p.ws + OFF_DEC);
    const int tid = threadIdx.x, k = tid & 127, seg = tid >> 7, t0 = seg * 16;
    const int wid = tid >> 6, lane = tid & 63, fr = lane & 15, fq = lane >> 4;
    LAS float* SEGT = (LAS float*)lds; LAS bf16_t* KdT = (LAS bf16_t*)(lds + 2048); LAS bf16_t* VTl = (LAS bf16_t*)(lds + 2048 + 18432);
    for (int cu = blockIdx.x; cu < NCHUNK_UNITS; cu += gridDim.x) {
        int row0, nvalid, h; chunk_unit(cu, row0, nvalid, h);
        float lf[16], bc[16]; float run = 0.f;
#pragma unroll
        for (int i = 0; i < 16; ++i) { const int t = t0 + i; lf[i] = (t < nvalid) ? (float)LOGF[(size_t)(row0 + t) * 512 + h * 128 + k] : 0.f; run += lf[i]; bc[i] = run; }
        SEGT[seg * 128 + k] = run;
        __syncthreads();
        float off = 0.f, tot = 0.f;
#pragma unroll
        for (int s = 0; s < 4; ++s) { const float x = SEGT[s * 128 + k]; tot += x; if (s < seg) off += x; }
        unsigned pk[8];
#pragma unroll
        for (int i = 0; i < 16; i += 2) { const float k0 = (1.0f - __expf(lf[i])) * __expf(tot - (bc[i] + off)), k1 = (1.0f - __expf(lf[i + 1])) * __expf(tot - (bc[i + 1] + off)); pk[i >> 1] = cvt_pk_bf16(k0, k1); }
        *(LAS u32x4*)(KdT + k * 72 + t0) = (u32x4){pk[0], pk[1], pk[2], pk[3]}; *(LAS u32x4*)(KdT + k * 72 + t0 + 8) = (u32x4){pk[4], pk[5], pk[6], pk[7]};
#pragma unroll
        for (int i = 0; i < 16; i += 2) { const int t = t0 + i; const unsigned a = (t < nvalid) ? V[(size_t)(row0 + t) * 512 + h * 128 + k] : 0u, b = (t + 1 < nvalid) ? V[(size_t)(row0 + t + 1) * 512 + h * 128 + k] : 0u; pk[i >> 1] = a | (b << 16); }
        *(LAS u32x4*)(VTl + k * 72 + t0) = (u32x4){pk[0], pk[1], pk[2], pk[3]}; *(LAS u32x4*)(VTl + k * 72 + t0 + 8) = (u32x4){pk[4], pk[5], pk[6], pk[7]};
        if (seg == 0) DEC[(size_t)cu * 128 + k] = __expf(tot);
        __syncthreads();
        const int vb = (wid >> 1) * 32, kb = (wid & 1) * 64;
        f32x4 acc[2][4];
#pragma unroll
        for (int i = 0; i < 2; ++i)
#pragma unroll
            for (int j = 0; j < 4; ++j) acc[i][j] = (f32x4){0.f, 0.f, 0.f, 0.f};
#pragma unroll
        for (int ks = 0; ks < 2; ++ks) { bf16x8 af[2], bfr[4];
#pragma unroll
            for (int i = 0; i < 2; ++i) af[i] = *(const LAS bf16x8*)(VTl + (vb + 16 * i + fr) * 72 + ks * 32 + fq * 8);
#pragma unroll
            for (int j = 0; j < 4; ++j) bfr[j] = *(const LAS bf16x8*)(KdT + (kb + 16 * j + fr) * 72 + ks * 32 + fq * 8);
#pragma unroll
            for (int i = 0; i < 2; ++i)
#pragma unroll
                for (int j = 0; j < 4; ++j) acc[i][j] = __builtin_amdgcn_mfma_f32_16x16x32_bf16(bfr[j], af[i], acc[i][j], 0, 0, 0); }
#pragma unroll
        for (int i = 0; i < 2; ++i)
#pragma unroll
            for (int j = 0; j < 4; ++j) { u32x2 w; w.x = cvt_pk_bf16(acc[i][j][0], acc[i][j][1]); w.y = cvt_pk_bf16(acc[i][j][2], acc[i][j][3]);
                *(u32x2*)(ST + (size_t)cu * 16384 + (vb + 16 * i + fr) * 128 + kb + 16 * j + 4 * fq) = w; }
        __syncthreads();
    }
}
__device__ __forceinline__ void hgrn_scan(const Params& p) {
    unsigned* ST = (unsigned*)p.out; const float* DEC = (const float*)(p.ws + OFF_DEC);
    float* out_hp = p.out + OUT_HGP; float* out_hs = p.out + OUT_HGS; const float* sh = p.in[4];
    const int gt = blockIdx.x * NTHREADS + threadIdx.x, GT = gridDim.x * NTHREADS;
    for (int task = gt; task < 16 * 8192; task += GT) {
        const int seq = task >> 13, pi = task & 8191, v = pi >> 6, k = (pi & 63) * 2;
        unsigned* stp = ST + ((size_t)seq * 128 * 16384 + v * 128 + k) / 2;
        const float* dp = DEC + (size_t)seq * 128 * 128 + k;
        float s0 = 0.f, s1 = 0.f;
        for (int c0 = 0; c0 < 128; c0 += 8) {
            unsigned kv[8]; float d0[8], d1[8];
#pragma unroll
            for (int j = 0; j < 8; ++j) { kv[j] = stp[(size_t)(c0 + j) * 8192]; d0[j] = dp[(c0 + j) * 128]; d1[j] = dp[(c0 + j) * 128 + 1]; }
#pragma unroll
            for (int j = 0; j < 8; ++j) { stp[(size_t)(c0 + j) * 8192] = cvt_pk_bf16(s0, s1); s0 = d0[j] * s0 + bf_lo(kv[j]); s1 = d1[j] * s1 + bf_hi(kv[j]); }
        }
        out_hp[(size_t)seq * 16384 + k * 128 + v] = s0; out_hp[(size_t)seq * 16384 + (k + 1) * 128 + v] = s1;
    }
    for (int task = gt; task < 64 * 8192; task += GT) {
        const int j = task >> 13, pi = task & 8191, v = pi >> 6, k = (pi & 63) * 2;
        unsigned* stp = ST + ((size_t)(2048 + j) * 16384 + v * 128 + k) / 2;
        const float* dp = DEC + (size_t)(2048 + j) * 128 + k;
        float s0 = sh[(size_t)j * 16384 + k * 128 + v], s1 = sh[(size_t)j * 16384 + (k + 1) * 128 + v];
        const unsigned kv = stp[0]; stp[0] = cvt_pk_bf16(s0, s1);
        s0 = dp[0] * s0 + bf_lo(kv); s1 = dp[1] * s1 + bf_hi(kv);
        out_hs[(size_t)j * 16384 + k * 128 + v] = s0; out_hs[(size_t)j * 16384 + (k + 1) * 128 + v] = s1;
    }
}
__device__ __forceinline__ void hgrn_pass3(const Params& p, LAS unsigned char* lds) {
    unsigned char* ar = p.ws + OFF_ARENA; const _Float16* LOGF = (const _Float16*)(ar + AR_LOGF); const bf16_t* Q = (const bf16_t*)(ar + AR_Q); const bf16_t* V = (const bf16_t*)(ar + AR_V);
    bf16_t* Gt = (bf16_t*)(ar + AR_G); const bf16_t* ST = (const bf16_t*)p.out; const float* hgn = p.in[11];
    const int tid = threadIdx.x, k = tid & 127, seg = tid >> 7, t0 = seg * 16;
    const int wid = tid >> 6, lane = tid & 63, fr = lane & 15, fq = lane >> 4;
    LAS float* SEGT = (LAS float*)lds; LAS float* RS = (LAS float*)(lds + 2048);
    LAS bf16_t* QD = (LAS bf16_t*)(lds + 4096); LAS bf16_t* KI = (LAS bf16_t*)(lds + 4096 + 17408); LAS bf16_t* VTl = (LAS bf16_t*)(lds + 4096 + 2 * 17408);
    LAS bf16_t* SC = (LAS bf16_t*)(lds + 4096 + 2 * 17408 + 18432); LAS bf16_t* STt = (LAS bf16_t*)(lds + 4096 + 2 * 17408 + 18432 + 9216);
    for (int cu = blockIdx.x; cu < NCHUNK_UNITS; cu += gridDim.x) {
        int row0, nvalid, h; chunk_unit(cu, row0, nvalid, h);
        float lf[16], bc[16]; float run = 0.f;
#pragma unroll
        for (int i = 0; i < 16; ++i) { const int t = t0 + i; lf[i] = (t < nvalid) ? (float)LOGF[(size_t)(row0 + t) * 512 + h * 128 + k] : 0.f; run += lf[i]; bc[i] = run; }
        SEGT[seg * 128 + k] = run;
#pragma unroll
        for (int q = 0; q < 4; ++q) { const int idx = tid + q * 512, v = idx >> 4, kc = (idx & 15) * 8; *(LAS u32x4*)(STt + v * 136 + kc) = *(const u32x4*)(ST + (size_t)cu * 16384 + v * 128 + kc); }
        __syncthreads();
        float off = 0.f;
#pragma unroll
        for (int s = 0; s < 4; ++s) { const float x = SEGT[s * 128 + k]; if (s < seg) off += x; }
#pragma unroll
        for (int i = 0; i < 16; ++i) { const int t = t0 + i; const float b = bc[i] + off; const float qv = (t < nvalid) ? bf2f(Q[(size_t)(row0 + t) * 512 + h * 128 + k]) : 0.f;
            QD[t * 136 + k] = f2bf(qv * __expf(b)); KI[t * 136 + k] = f2bf((1.0f - __expf(lf[i])) * __expf(fminf(-b, 80.f))); }
        unsigned pk[8];
#pragma unroll
        for (int i = 0; i < 16; i += 2) { const int t = t0 + i; const unsigned a = (t < nvalid) ? V[(size_t)(row0 + t) * 512 + h * 128 + k] : 0u, b = (t + 1 < nvalid) ? V[(size_t)(row0 + t + 1) * 512 + h * 128 + k] : 0u; pk[i >> 1] = a | (b << 16); }
        *(LAS u32x4*)(VTl + k * 72 + t0) = (u32x4){pk[0], pk[1], pk[2], pk[3]}; *(LAS u32x4*)(VTl + k * 72 + t0 + 8) = (u32x4){pk[4], pk[5], pk[6], pk[7]};
        __syncthreads();
        const int tt = wid & 3;
#pragma unroll
        for (int sti = 0; sti < 2; ++sti) { const int st = (wid >> 2) * 2 + sti; f32x4 a = (f32x4){0.f, 0.f, 0.f, 0.f};
            if (st <= tt) {
#pragma unroll
                for (int ks = 0; ks < 4; ++ks) { const bf16x8 bfr = *(const LAS bf16x8*)(KI + (st * 16 + fr) * 136 + ks * 32 + fq * 8), af = *(const LAS bf16x8*)(QD + (tt * 16 + fr) * 136 + ks * 32 + fq * 8);
                    a = __builtin_amdgcn_mfma_f32_16x16x32_bf16(bfr, af, a, 0, 0, 0); } }
            const int t = tt * 16 + fr, s = st * 16 + 4 * fq;
#pragma unroll
            for (int j = 0; j < 4; ++j) if (s + j > t) a[j] = 0.f;
            u32x2 w; w.x = cvt_pk_bf16(a[0], a[1]); w.y = cvt_pk_bf16(a[2], a[3]); *(LAS u32x2*)(SC + t * 72 + s) = w; }
        __syncthreads();
        const int vt0 = (wid >> 2) * 4;
        f32x4 o[4];
#pragma unroll
        for (int vi = 0; vi < 4; ++vi) o[vi] = (f32x4){0.f, 0.f, 0.f, 0.f};
#pragma unroll
        for (int ks = 0; ks < 2; ++ks) { const bf16x8 af = *(const LAS bf16x8*)(SC + (tt * 16 + fr) * 72 + ks * 32 + fq * 8);
#pragma unroll
            for (int vi = 0; vi < 4; ++vi) { const bf16x8 bfr = *(const LAS bf16x8*)(VTl + ((vt0 + vi) * 16 + fr) * 72 + ks * 32 + fq * 8); o[vi] = __builtin_amdgcn_mfma_f32_16x16x32_bf16(bfr, af, o[vi], 0, 0, 0); } }
#pragma unroll
        for (int ks = 0; ks < 4; ++ks) { const bf16x8 af = *(const LAS bf16x8*)(QD + (tt * 16 + fr) * 136 + ks * 32 + fq * 8);
#pragma unroll
            for (int vi = 0; vi < 4; ++vi) { const bf16x8 bfr = *(const LAS bf16x8*)(STt + ((vt0 + vi) * 16 + fr) * 136 + ks * 32 + fq * 8); o[vi] = __builtin_amdgcn_mfma_f32_16x16x32_bf16(bfr, af, o[vi], 0, 0, 0); } }
        float ss = 0.f;
#pragma unroll
        for (int vi = 0; vi < 4; ++vi) ss += (o[vi][0] * o[vi][0] + o[vi][1] * o[vi][1]) + (o[vi][2] * o[vi][2] + o[vi][3] * o[vi][3]);
        ss += __shfl_xor(ss, 16); ss += __shfl_xor(ss, 32);
        const int t = tt * 16 + fr;
        if (fq == 0) RS[t * 2 + (wid >> 2)] = ss;
        __syncthreads();
        const float rstd = rsqrtf((RS[t * 2] + RS[t * 2 + 1]) * (1.0f / 128.0f) + EPS);
        if (t < nvalid) {
#pragma unroll
            for (int vi = 0; vi < 4; ++vi) { const int v = (vt0 + vi) * 16 + 4 * fq; bf16_t* gp = Gt + (size_t)(row0 + t) * 512 + h * 128 + v;
                const u32x2 gw = *(const u32x2*)gp; const f32x4 nm = *(const f32x4*)(hgn + v);
                u32x2 w; w.x = cvt_pk_bf16(o[vi][0] * rstd * nm[0] * bf_lo(gw.x), o[vi][1] * rstd * nm[1] * bf_hi(gw.x)); w.y = cvt_pk_bf16(o[vi][2] * rstd * nm[2] * bf_lo(gw.y), o[vi][3] * rstd * nm[3] * bf_hi(gw.y));
                *(u32x2*)gp = w; } }
        __syncthreads();
    }
}
__device__ __forceinline__ void final_phase(const Params& p) {
    const bf16_t* X = (const bf16_t*)(p.ws + OFF_ARENA + AR_X2B); const float* ss = (const float*)(p.ws + OFF_SS4); const float* g = p.in[24];
    const int gt = blockIdx.x * NTHREADS + threadIdx.x, GT = gridDim.x * NTHREADS;
    for (int idx = gt; idx < NTOK * 128; idx += GT) {
        const int row = idx >> 7, c8 = (idx & 127) * 8; f32x4 a, b; load8_bf16(X + (size_t)row * 1024 + c8, a, b);
        const float rs = rsqrtf(sum16(ss + (size_t)row * 16) * (1.0f / 1024.0f) + EPS); const f32x4 g0 = *(const f32x4*)(g + c8), g1 = *(const f32x4*)(g + c8 + 4);
        float* o = p.out + OUT_Y + (size_t)row * 1024 + c8; *(f32x4*)o = a * rs * g0; *(f32x4*)(o + 4) = b * rs * g1;
    }
}

#ifndef STOP_AFTER
#define STOP_AFTER 0
#endif
__global__ void __launch_bounds__(NTHREADS, 2) fwd_megakernel(Params p) {
    extern __shared__ __attribute__((aligned(16))) unsigned char lds_raw[];
    LAS unsigned char* lds = (LAS unsigned char*)lds_raw;
    cg::grid_group grid = cg::this_grid();
    unsigned char* ws = p.ws; unsigned char* ar = ws + OFF_ARENA;
    const int G = gridDim.x, bx = blockIdx.x;

    prepass(p, lds);
    grid.sync();
    if (STOP_AFTER == 1) return;
    {
        pg8::Gemm g{(const bf16_t*)(ws + OFF_XB), (const bf16_t*)(ws + OFF_WIN), 1024, 1024, 1024}; pg8::StaticOrder S; S.init(g, NTOK, 5632, G, bx);
        EpiProj E{(bf16_t*)(ar + AR_CB), (bf16_t*)(ar + AR_U), (bf16_t*)(ar + AR_Q), (bf16_t*)(ar + AR_V), (bf16_t*)(ar + AR_G), (bf16_t*)(ar + AR_GA), (bf16_t*)(ar + AR_GB), (_Float16*)(ar + AR_LOGF),
                  (const float*)(ws + OFF_RSTD1), (const float*)(ws + OFF_LB)};
        pg8::gemm_phase(lds, g, S, E);
        pg8::Gemm g2{(const bf16_t*)(ws + OFF_MEMB), (const bf16_t*)(ws + OFF_WXKV), 1024, 1024, 1024}; pg8::StaticOrder S2; S2.init(g2, 1024, 2048, G, (bx + G / 2) % G);
        EpiMemKV E2{p.out + OUT_MEMK, p.out + OUT_MEMV, (bf16_t*)(ws + OFF_KB), (bf16_t*)(ws + OFF_VT)};
        pg8::gemm_phase(lds, g2, S2, E2);
    }
    grid.sync();
    if (STOP_AFTER == 2) return;
    conv_phase(p);
#ifndef SKIP_PASS1
    hgrn_pass1(p, lds);
#else
    { const u32x4* src = (const u32x4*)(ar + 4 * SZ_S); u32x4* dst = (u32x4*)p.out; const size_t n = 4 * SZ_S / 16;
      for (size_t i = (size_t)bx * NTHREADS + threadIdx.x; i < n; i += (size_t)G * NTHREADS) dst[i] = src[i]; }
#endif
    grid.sync();
    if (STOP_AFTER == 3) return;
    hgrn_scan(p);
    grid.sync();
    if (STOP_AFTER == 4) return;
    hgrn_pass3(p, lds);
    grid.sync();
    if (STOP_AFTER == 5) return;
    {
        pg8::Gemm g{(const bf16_t*)(ar + AR_CB), (const bf16_t*)(ws + OFF_WCONV), 512, 512, 512}; pg8::StaticOrder S; S.init(g, NTOK, 1024, G, bx);
        EpiYA E{(bf16_t*)(ar + AR_GA)};
        pg8::gemm_phase(lds, g, S, E);
        pg8::Gemm g2{(const bf16_t*)(ar + AR_G), (const bf16_t*)(ws + OFF_WHG), 512, 512, 512}; pg8::StaticOrder S2; S2.init(g2, NTOK, 1024, G, bx);
        EpiMerge E2{(bf16_t*)(ar + AR_GA), (const bf16_t*)(ar + AR_GB)};
        pg8::gemm_phase(lds, g2, S2, E2);
    }
    grid.sync();
    if (STOP_AFTER == 6) return;
    {
        pg8::Gemm g{(const bf16_t*)(ar + AR_GA), (const bf16_t*)(ws + OFF_WO), 1024, 1024, 1024}; pg8::StaticOrder S; S.init(g, NTOK, 1024, G, bx);
        EpiRes E{(const bf16_t*)(ws + OFF_XB), (bf16_t*)(ar + AR_X1B), (float*)(ws + OFF_SS2)};
        pg8::gemm_phase(lds, g, S, E);
    }
    grid.sync();
    if (STOP_AFTER == 7) return;
    {
        pg8::Gemm g{(const bf16_t*)(ar + AR_X1B), (const bf16_t*)(ws + OFF_WXQ), 1024, 1024, 1024}; pg8::StaticOrder S; S.init(g, NTOK, 1024, G, bx);
        EpiScaleRow<false, 1024> E{(bf16_t*)(ar + AR_QB), (const float*)(ws + OFF_SS2)};
        pg8::gemm_phase(lds, g, S, E);
    }
    grid.sync();
    if (STOP_AFTER == 8) return;
    {
        pg8::Gemm g{(const bf16_t*)(ar + AR_QB), (const bf16_t*)(ws + OFF_KB), 1024, 1024, 256}; pg8::AttnOrder S{G, bx, g.A, g.Bt, 0};
        EpiSoftmax E{(bf16_t*)(ar + AR_P), (float*)(ws + OFF_LSUM)};
        pg8::gemm_phase(lds, g, S, E);
    }
    grid.sync();
    if (STOP_AFTER == 9) return;
    {
        pg8::Gemm g{(const bf16_t*)(ar + AR_P), (const bf16_t*)(ws + OFF_VT), 1024, 256, 256}; pg8::AttnOrder S{G, bx, g.A, g.Bt, 1};
        EpiPV E{(bf16_t*)(ar + AR_AO), (const float*)(ws + OFF_LSUM)};
        pg8::gemm_phase(lds, g, S, E);
    }
    grid.sync();
    if (STOP_AFTER == 10) return;
    {
        pg8::Gemm g{(const bf16_t*)(ar + AR_AO), (const bf16_t*)(ws + OFF_WXO), 1024, 1024, 1024}; pg8::StaticOrder S; S.init(g, NTOK, 1024, G, bx);
        EpiRes E{(const bf16_t*)(ar + AR_X1B), (bf16_t*)(ar + AR_X2B), (float*)(ws + OFF_SS3)};
        pg8::gemm_phase(lds, g, S, E);
    }
    grid.sync();
    if (STOP_AFTER == 11) return;
    {
        pg8::Gemm g{(const bf16_t*)(ar + AR_X2B), (const bf16_t*)(ws + OFF_WUP), 1024, 1024, 1024}; pg8::StaticOrder S; S.init(g, NTOK, 4096, G, bx);
        EpiScaleRow<true, 4096> E{(bf16_t*)(ar + AR_HID), (const float*)(ws + OFF_SS3)};
        pg8::gemm_phase(lds, g, S, E);
    }
    grid.sync();
    if (STOP_AFTER == 12) return;
    {
        pg8::Gemm g{(const bf16_t*)(ar + AR_HID), (const bf16_t*)(ws + OFF_WDOWN), 4096, 4096, 4096}; pg8::StaticOrder S; S.init(g, NTOK, 1024, G, bx);
        EpiRes E{(const bf16_t*)(ar + AR_X2B), (bf16_t*)(ar + AR_X2B), (float*)(ws + OFF_SS4)};
        pg8::gemm_phase(lds, g, S, E);
    }
    grid.sync();
    if (STOP_AFTER == 13) return;
    final_phase(p);
}

extern "C" void kernel_launch(void* const* d_in, const int* in_sizes, int n_in, void* d_out, int out_size, void* d_ws, size_t ws_size, hipStream_t stream) {
    static int grid_blocks = 0;
    if (grid_blocks == 0) {
        if (n_in != 25 || ws_size < WS_END) { fprintf(stderr, "kernel_launch: unexpected inputs (n_in %d, ws %zu, need %zu)\n", n_in, ws_size, (size_t)WS_END); grid_blocks = -1; return; }
        int dev = 0, cus = 0, per_cu = 0;
        hipGetDevice(&dev); hipDeviceGetAttribute(&cus, hipDeviceAttributeMultiprocessorCount, dev);
        if (hipFuncSetAttribute((const void*)fwd_megakernel, hipFuncAttributeMaxDynamicSharedMemorySize, LDS_BYTES) != hipSuccess) { fprintf(stderr, "kernel_launch: hipFuncSetAttribute failed\n"); grid_blocks = -1; return; }
        if (hipOccupancyMaxActiveBlocksPerMultiprocessor(&per_cu, (const void*)fwd_megakernel, NTHREADS, LDS_BYTES) != hipSuccess || per_cu < 1) { fprintf(stderr, "kernel_launch: occupancy query gives %d\n", per_cu); per_cu = 1; }
        (void)hipGetLastError();
        grid_blocks = cus * 1;
    }
    if (grid_blocks < 0) return;
    Params p{};
    for (int i = 0; i < 25; ++i) p.in[i] = (const float*)d_in[i];
    p.out = (float*)d_out; p.ws = (unsigned char*)d_ws;
    void* args[] = {&p};
    hipError_t e = hipLaunchCooperativeKernel((const void*)fwd_megakernel, dim3(grid_blocks), dim3(NTHREADS), args, LDS_BYTES, stream);
    if (e != hipSuccess) fprintf(stderr, "cooperative launch failed: %s (grid %d)\n", hipGetErrorString(e), grid_blocks);
}
```
